# Optimizing an MI355X kernel written in HIP

```python
import math
import jax
import jax.numpy as jnp
from jax import lax
import numpy as np

D_MODEL = 4096
BATCH = 16
SEQ = 256
DEPTH = 1
DEC_BATCH = 2
DEC_SEQ = 2048
PAST_LEN = 512

GRID_W = 64
GLA_HEADS = 8
GLA_DK = 128
GLA_DV = 256
GLA_WIDTH = GLA_HEADS * GLA_DV
GLA_QK = GLA_HEADS * GLA_DK
GLA_RANK = 16
GLA_TAU = 16.0
GLA_CHUNK = 64
GLA_COLS = 2 * GLA_QK + 2 * GLA_WIDTH + 2 * GLA_RANK
S5_WIDTH = D_MODEL - GLA_WIDTH
S5_CH = 16
S5_GROUPS = S5_WIDTH // S5_CH
S5_STATE = 64
S5_DT_MIN = 1e-3
S5_DT_MAX = 1e-1
D_IN = GLA_COLS + S5_WIDTH
D_FF = 11008
N_MOD = 9
EPS = 1e-6
ROPE_THETA = 10000.0
F32 = jnp.float32

kernel_name = "hybrid_gla_s5_diffusion_step"


def rmsnorm(x, w):
    xf = x.astype(F32)
    y = xf * lax.rsqrt(jnp.mean(xf * xf, axis=-1, keepdims=True) + EPS)
    return (y * w.astype(F32)).astype(x.dtype)


def ada_modulation(cvec, w_ada, b_ada):
    m = jax.nn.silu(cvec) @ w_ada + b_ada
    return m.reshape(cvec.shape[0], N_MOD, D_MODEL)[:, :, None, :]


def swiglu(h, w_gu, w_down):
    gate, up = jnp.split(h @ w_gu, 2, axis=-1)
    return (jax.nn.silu(gate) * up) @ w_down


def rope_1d(x, p):
    half = x.shape[-1] // 2
    freqs = ROPE_THETA ** (-jnp.arange(half, dtype=F32) / half)
    ang = p.astype(F32)[:, None] * freqs
    cos, sin = jnp.cos(ang), jnp.sin(ang)
    x1, x2 = x[..., :half], x[..., half:]
    return jnp.concatenate([x1 * cos - x2 * sin, x1 * sin + x2 * cos], axis=-1)


def rope_2d(x, pos):
    row, col = pos
    h = x.shape[-1] // 2
    return jnp.concatenate([rope_1d(x[..., :h], row), rope_1d(x[..., h:], col)], axis=-1)


def gla_chunked(q, k, v, log_a, s0):
    bsz, nh, seq, _ = q.shape
    n_chunks = seq // GLA_CHUNK

    def to_chunks(t):
        return jnp.moveaxis(t.reshape(bsz, nh, n_chunks, GLA_CHUNK, t.shape[-1]), 2, 0)

    causal = jnp.tril(jnp.ones((GLA_CHUNK, GLA_CHUNK), dtype=bool))
    ref_idx = GLA_CHUNK // 2 - 1

    def step(s, inp):
        qi, ki, vi, gi = inp
        bcum = jnp.cumsum(gi, axis=2)
        ref = bcum[:, :, ref_idx:ref_idx + 1]
        b_last = bcum[:, :, -1:]
        att = jnp.einsum("bhid,bhjd->bhij", qi * jnp.exp(bcum - ref), ki * jnp.exp(ref - bcum))
        att = jnp.where(causal, att, 0.0)
        o = (jnp.einsum("bhij,bhjv->bhiv", att, vi)
             + jnp.einsum("bhid,bhdv->bhiv", qi * jnp.exp(bcum), s))
        s_new = (jnp.exp(b_last)[:, :, 0, :, None] * s
                 + jnp.einsum("bhjd,bhjv->bhdv", ki * jnp.exp(b_last - bcum), vi))
        return s_new, o

    s_fin, o_chunks = lax.scan(step, s0.astype(F32),
                               (to_chunks(q), to_chunks(k), to_chunks(v), to_chunks(log_a)))
    o = jnp.moveaxis(o_chunks, 0, 2).reshape(bsz, nh, seq, v.shape[-1])
    return o, s_fin


def gla_mixer(p, w_gate_lr2, b_gate, gla_norm_w, s0, pos):
    bsz, seq, _ = p.shape
    o0 = 2 * GLA_QK
    q = p[..., :GLA_QK]
    k = p[..., GLA_QK:o0]
    v = p[..., o0:o0 + GLA_WIDTH]
    g = p[..., o0 + GLA_WIDTH:o0 + 2 * GLA_WIDTH]
    lr = p[..., o0 + 2 * GLA_WIDTH:]

    def heads(t):
        return t.reshape(bsz, seq, GLA_HEADS, -1).transpose(0, 2, 1, 3).astype(F32)

    q, k, v = heads(q), heads(k), heads(v)
    if pos is not None:
        q = rope_2d(q, pos)
        k = rope_2d(k, pos)
    q = q * (GLA_DK ** -0.5)
    if s0 is None:
        s0 = jnp.zeros((bsz, 2, GLA_HEADS, GLA_DK, GLA_DV), F32)
    o = jnp.zeros((bsz, GLA_HEADS, seq, GLA_DV), F32)
    finals = []
    for d in range(2):
        logit = lr[..., d * GLA_RANK:(d + 1) * GLA_RANK] @ w_gate_lr2[d] + b_gate[d]
        log_a = heads(jax.nn.log_sigmoid(logit.astype(F32)) / GLA_TAU)
        if d == 0:
            od, sd = gla_chunked(q, k, v, log_a, s0[:, 0])
        else:
            od, sd = gla_chunked(jnp.flip(q, 2), jnp.flip(k, 2), jnp.flip(v, 2),
                                 jnp.flip(log_a, 2), s0[:, 1])
            od = jnp.flip(od, 2)
        o = o + od
        finals.append(sd)
    o = rmsnorm(o, gla_norm_w)
    o = o.transpose(0, 2, 1, 3).reshape(bsz, seq, GLA_WIDTH) * jax.nn.silu(g.astype(F32))
    return o, jnp.stack(finals, axis=1)


def s5_combine(e1, e2):
    a1r, a1i, b1r, b1i = e1
    a2r, a2i, b2r, b2i = e2
    return (a2r * a1r - a2i * a1i, a2r * a1i + a2i * a1r,
            a2r * b1r - a2i * b1i + b2r, a2r * b1i + a2i * b1r + b2i)


def s5_mixer(u, lam_re, lam_im, log_dt, b_re, b_im, c_re, c_im, d_skip, w_glu, b_glu, h0_re, h0_im):
    bsz, seq, _ = u.shape
    ug = u.astype(F32).reshape(bsz, seq, S5_GROUPS, S5_CH)
    y = ug * d_skip.astype(F32).reshape(S5_GROUPS, S5_CH)
    finals_re, finals_im = [], []
    for d in range(2):
        lr = lam_re[d].astype(F32)
        li = lam_im[d].astype(F32)
        dt = jnp.exp(log_dt[d].astype(F32))[:, None]
        mag = jnp.exp(lr * dt)
        ar = mag * jnp.cos(li * dt)
        ai = mag * jnp.sin(li * dt)
        den = lr * lr + li * li
        fr = ((ar - 1.0) * lr + ai * li) / den
        fi = (ai * lr - (ar - 1.0) * li) / den
        br = b_re[d].astype(F32)
        bi = b_im[d].astype(F32)
        bbr = fr[..., None] * br - fi[..., None] * bi
        bbi = fr[..., None] * bi + fi[..., None] * br
        bu_r = jnp.einsum("blgc,gpc->blgp", ug, bbr)
        bu_i = jnp.einsum("blgc,gpc->blgp", ug, bbi)
        a_r = jnp.broadcast_to(ar, bu_r.shape)
        a_i = jnp.broadcast_to(ai, bu_r.shape)
        pa_r, pa_i, h_r, h_i = lax.associative_scan(
            s5_combine, (a_r, a_i, bu_r, bu_i), axis=1, reverse=(d == 1))
        if h0_re is not None:
            g_r = h0_re[:, d].astype(F32)[:, None]
            g_i = h0_im[:, d].astype(F32)[:, None]
            h_r, h_i = (h_r + pa_r * g_r - pa_i * g_i, h_i + pa_r * g_i + pa_i * g_r)
        else:
            edge = -1 if d == 0 else 0
            finals_re.append(h_r[:, edge])
            finals_im.append(h_i[:, edge])
        y = (y + jnp.einsum("blgp,gcp->blgc", h_r, c_re[d].astype(F32))
             - jnp.einsum("blgp,gcp->blgc", h_i, c_im[d].astype(F32)))
    y = jax.nn.gelu(y.reshape(bsz, seq, S5_WIDTH))
    y = y * jax.nn.sigmoid(y @ w_glu + b_glu)
    finals = (jnp.stack(finals_re, axis=1), jnp.stack(finals_im, axis=1)) if h0_re is None else None
    return y, finals


def trunk_layer(x, mod, lw, gla_s0, s5_h0_re, s5_h0_im, pos):
    nw = lw["norm_w"]
    h = rmsnorm(x, nw[0]) * (1.0 + mod[:, 1]) + mod[:, 0]
    x = x + 0.5 * mod[:, 2] * rmsnorm(swiglu(h, lw["w_ffn1_gu"], lw["w_ffn1_down"]), nw[1])
    h = rmsnorm(x, nw[2]) * (1.0 + mod[:, 4]) + mod[:, 3]
    proj = h @ lw["w_in"]
    o_gla, gla_fin = gla_mixer(proj[..., :GLA_COLS], lw["w_gate_lr2"], lw["b_gate"],
                               lw["gla_norm_w"], gla_s0, pos)
    o_s5, s5_fin = s5_mixer(proj[..., GLA_COLS:], lw["s5_lam_re"], lw["s5_lam_im"], lw["s5_log_dt"],
                            lw["s5_b_re"], lw["s5_b_im"], lw["s5_c_re"], lw["s5_c_im"], lw["s5_d"],
                            lw["w_glu"], lw["b_glu"], s5_h0_re, s5_h0_im)
    mix = jnp.concatenate([o_gla, o_s5], axis=-1).astype(x.dtype) @ lw["w_out"]
    x = x + mod[:, 5] * rmsnorm(mix, nw[3])
    h = rmsnorm(x, nw[4]) * (1.0 + mod[:, 7]) + mod[:, 6]
    x = x + 0.5 * mod[:, 8] * rmsnorm(swiglu(h, lw["w_ffn2_gu"], lw["w_ffn2_down"]), nw[5])
    return x, gla_fin, s5_fin


def setup_inputs(seed: int = 0) -> dict:
    key = jax.random.key(seed)
    ks = iter(jax.random.split(key, 32))

    def nrm(shape, scale):
        return scale * jax.random.normal(next(ks), shape, F32)

    G, P, CH = S5_GROUPS, S5_STATE, S5_CH
    x_prompt = nrm((BATCH, SEQ, D_MODEL), 1.0)
    x_sample = nrm((DEC_BATCH, DEC_SEQ, D_MODEL), 1.0)
    c = nrm((DEC_BATCH, D_MODEL), 1.0)
    state_gla = nrm((DEC_BATCH, DEPTH, 2, GLA_HEADS, GLA_DK, GLA_DV), 1.0)
    state_s5_re = nrm((DEC_BATCH, DEPTH, 2, G, P), 1.0)
    state_s5_im = nrm((DEC_BATCH, DEPTH, 2, G, P), 1.0)
    c_ctx = nrm((D_MODEL,), 1.0)
    w_ada = nrm((DEPTH, D_MODEL, N_MOD * D_MODEL), 0.5 * D_MODEL ** -0.5)
    b_ada = nrm((DEPTH, N_MOD * D_MODEL), 0.02)
    norm_w = 1.0 + nrm((DEPTH, 6, D_MODEL), 0.02)
    w_ffn1_gu = nrm((DEPTH, D_MODEL, 2 * D_FF), D_MODEL ** -0.5)
    w_ffn1_down = nrm((DEPTH, D_FF, D_MODEL), D_FF ** -0.5)
    w_in = nrm((DEPTH, D_MODEL, D_IN), D_MODEL ** -0.5)
    w_gate_lr2 = nrm((DEPTH, 2, GLA_RANK, GLA_QK), GLA_RANK ** -0.5)
    b_gate = nrm((DEPTH, 2, GLA_QK), 0.1)
    gla_norm_w = 1.0 + nrm((DEPTH, GLA_DV), 0.02)
    s5_lam_re = -0.5 + nrm((DEPTH, 2, G, P), 0.01)
    s5_lam_im = math.pi * jnp.arange(P, dtype=F32) + nrm((DEPTH, 2, G, P), 0.01)
    s5_log_dt = jax.random.uniform(next(ks), (DEPTH, 2, G), F32,
                                   math.log(S5_DT_MIN), math.log(S5_DT_MAX))
    s5_b_re = nrm((DEPTH, 2, G, P, CH), 0.7 * CH ** -0.5)
    s5_b_im = nrm((DEPTH, 2, G, P, CH), 0.7 * CH ** -0.5)
    s5_c_re = nrm((DEPTH, 2, G, CH, P), 0.7 * P ** -0.5)
    s5_c_im = nrm((DEPTH, 2, G, CH, P), 0.7 * P ** -0.5)
    s5_d = nrm((DEPTH, S5_WIDTH), 0.5)
    w_glu = nrm((DEPTH, S5_WIDTH, S5_WIDTH), S5_WIDTH ** -0.5)
    b_glu = nrm((DEPTH, S5_WIDTH), 0.02)
    w_out = nrm((DEPTH, D_MODEL, D_MODEL), D_MODEL ** -0.5)
    w_ffn2_gu = nrm((DEPTH, D_MODEL, 2 * D_FF), D_MODEL ** -0.5)
    w_ffn2_down = nrm((DEPTH, D_FF, D_MODEL), D_FF ** -0.5)
    return {"x_prompt": x_prompt, "x_sample": x_sample, "c": c,
            "state_gla": state_gla, "state_s5_re": state_s5_re, "state_s5_im": state_s5_im,
            "c_ctx": c_ctx, "w_ada": w_ada, "b_ada": b_ada, "norm_w": norm_w,
            "w_ffn1_gu": w_ffn1_gu, "w_ffn1_down": w_ffn1_down, "w_in": w_in,
            "w_gate_lr2": w_gate_lr2, "b_gate": b_gate, "gla_norm_w": gla_norm_w,
            "s5_lam_re": s5_lam_re, "s5_lam_im": s5_lam_im, "s5_log_dt": s5_log_dt,
            "s5_b_re": s5_b_re, "s5_b_im": s5_b_im, "s5_c_re": s5_c_re, "s5_c_im": s5_c_im,
            "s5_d": s5_d, "w_glu": w_glu, "b_glu": b_glu, "w_out": w_out,
            "w_ffn2_gu": w_ffn2_gu, "w_ffn2_down": w_ffn2_down}


def reference(x_prompt, x_sample, c, state_gla, state_s5_re, state_s5_im, c_ctx, w_ada, b_ada,
              norm_w, w_ffn1_gu, w_ffn1_down, w_in, w_gate_lr2, b_gate, gla_norm_w,
              s5_lam_re, s5_lam_im, s5_log_dt, s5_b_re, s5_b_im, s5_c_re, s5_c_im, s5_d,
              w_glu, b_glu, w_out, w_ffn2_gu, w_ffn2_down):
    layers = [dict(norm_w=norm_w[i], w_ffn1_gu=w_ffn1_gu[i], w_ffn1_down=w_ffn1_down[i],
                   w_in=w_in[i], w_gate_lr2=w_gate_lr2[i], b_gate=b_gate[i],
                   gla_norm_w=gla_norm_w[i], s5_lam_re=s5_lam_re[i], s5_lam_im=s5_lam_im[i],
                   s5_log_dt=s5_log_dt[i], s5_b_re=s5_b_re[i], s5_b_im=s5_b_im[i],
                   s5_c_re=s5_c_re[i], s5_c_im=s5_c_im[i], s5_d=s5_d[i], w_glu=w_glu[i],
                   b_glu=b_glu[i], w_out=w_out[i], w_ffn2_gu=w_ffn2_gu[i],
                   w_ffn2_down=w_ffn2_down[i])
              for i in range(DEPTH)]

    y_prompt = x_prompt
    gla_list, re_list, im_list = [], [], []
    for i in range(DEPTH):
        mod_ctx = ada_modulation(c_ctx[None, :], w_ada[i], b_ada[i])
        y_prompt, g_fin, s_fin = trunk_layer(y_prompt, mod_ctx, layers[i], None, None, None, None)
        gla_list.append(g_fin)
        re_list.append(s_fin[0])
        im_list.append(s_fin[1])
    new_state_gla = jnp.stack(gla_list, axis=1)
    new_state_s5_re = jnp.stack(re_list, axis=1)
    new_state_s5_im = jnp.stack(im_list, axis=1)

    rows = x_sample.shape[1] // GRID_W
    pos = (jnp.repeat(jnp.arange(rows), GRID_W), jnp.tile(jnp.arange(GRID_W), rows))
    y_sample = x_sample
    for i in range(DEPTH):
        mod_lat = ada_modulation(c, w_ada[i], b_ada[i])
        y_sample, _, _ = trunk_layer(y_sample, mod_lat, layers[i], state_gla[:, i],
                                     state_s5_re[:, i], state_s5_im[:, i], pos)
    return (y_prompt, y_sample, new_state_gla, new_state_s5_re, new_state_s5_im)
```

```cpp
#include <hip/hip_runtime.h>
#include <cstdio>
#include <cstdint>
__device__ __forceinline__ int lane_now() { int l; asm volatile("v_mbcnt_lo_u32_b32 %0, -1, 0\n\tv_mbcnt_hi_u32_b32 %0, -1, %0" : "=v"(l)); return l; }
namespace pg8 {
#define PG8_LAS __attribute__((address_space(3)))
typedef unsigned short bf16_t;
typedef short bf16x8 __attribute__((ext_vector_type(8)));
typedef float f32x4 __attribute__((ext_vector_type(4)));
typedef unsigned u32x4 __attribute__((ext_vector_type(4)));
constexpr int BM = 256, BK = 64, HALF = 128, HTB = HALF * BK * 2  , STAGE_BYTES = 8 * HTB, NXCD = 8, WGM = 8;

__host__ __device__ __forceinline__ int lds_byte(int r, int c) { const int st = (r >> 4) * 2 + (c >> 5), rr = r & 15, cc = c & 31, ob = rr * 64 + cc * 2; return st * 1024 + (ob ^ (((ob >> 9) & 1) << 5)); }
__host__ __device__ __forceinline__ void stage_rc(int b, int& R, int& C) { const int st = b / 1024, sb = b % 1024, swz = sb ^ (((sb >> 9) & 1) << 5); R = (st >> 1) * 16 + swz / 64; C = (st & 1) * 32 + (swz % 64) / 2; }
__host__ __device__ __forceinline__ int perm32(int rho) { const int n = rho >> 4, i = rho & 15; return 8 * (i >> 2) + 4 * n + (i & 3); }

struct Unit { int pm, pn; };
struct Gemm { const bf16_t* A; const bf16_t* Bt; int M, N, K; };

struct StaticOrder {
    int nM, nN, nwg, G, c;
    __host__ __device__ void init(int M, int N, int G_, int c_) { nM = M / BM; nN = N / BM; nwg = nM * nN; G = G_; c = c_; }
    __host__ __device__ bool next(int i, Unit& u) const {
        const long L = (long)i * G + c; if (L >= nwg) return false;
        int wgid = (int)L; { const int q = nwg / NXCD, r = nwg % NXCD, xcd = wgid % NXCD, off = wgid / NXCD; wgid = (xcd < r ? xcd * (q + 1) : r * (q + 1) + (xcd - r) * q) + off; }
        const int nig = WGM * nN, gid = wgid / nig, fm = gid * WGM, gsz = (nM - fm) < WGM ? (nM - fm) : WGM;
        u.pm = fm + ((wgid % nig) % gsz); u.pn = (wgid % nig) / gsz; return true;
    }
    __device__ __forceinline__ void a_ready(const Unit&) const {}
    __device__ __forceinline__ void done(const Unit&) const {}
};

typedef __bf16 hbf16x2_t __attribute__((ext_vector_type(2))); typedef float f32x2_t __attribute__((ext_vector_type(2)));
__device__ __forceinline__ unsigned cvt_pk_bf16(float lo, float hi) { const f32x2_t v = {lo, hi}; return __builtin_bit_cast(unsigned, __builtin_convertvector(v, hbf16x2_t)); }
typedef float f32x2 __attribute__((ext_vector_type(2)));
typedef int i32x4 __attribute__((ext_vector_type(4)));
typedef int i32x8 __attribute__((ext_vector_type(8)));
typedef unsigned u32x2 __attribute__((ext_vector_type(2)));
template <int QT> struct AccOf { typedef f32x4 type; };
template <> struct AccOf<2> { typedef i32x4 type; };
__device__ __forceinline__ i32x8 cat8(bf16x8 lo, bf16x8 hi) { const i32x4 a = __builtin_bit_cast(i32x4, lo), b = __builtin_bit_cast(i32x4, hi); return __builtin_shufflevector(a, b, 0, 1, 2, 3, 4, 5, 6, 7); }
__device__ __forceinline__ float sigmoid_f(float z) { return __builtin_amdgcn_rcpf(1.0f + __expf(-z)); }
constexpr float ACT_Q = 4.0f;
struct EpiSwiGLU {
    static constexpr bool PERM = true, AFTER_DRAIN = false;
    unsigned char* O; int ldc; const float* sA; const float* sW;
    __device__ __forceinline__ void operator()(const i32x4 (&acc)[2][2][4][2], const Unit& u, int wr, int wc, int fr, int fq) const {
        const int row0 = u.pm * BM + wr * 64 + fr, col0 = u.pn * HALF + wc * 32 + 8 * fq, wrow0 = u.pn * BM + wc * 32 + 8 * fq;
        f32x4 sg[2], su[2];
#pragma unroll
        for (int n = 0; n < 2; ++n) { sg[n] = *(const f32x4*)(sW + wrow0 + 4 * n); su[n] = *(const f32x4*)(sW + wrow0 + HALF + 4 * n); }
#pragma unroll
        for (int ai = 0; ai < 2; ++ai)
#pragma unroll
            for (int m = 0; m < 4; ++m) { const int r = row0 + ai * HALF + m * 16; const float sa = sA[r];
                float o[8];
#pragma unroll
                for (int n = 0; n < 2; ++n)
#pragma unroll
                    for (int j = 0; j < 4; ++j) { const float g = (float)acc[ai][0][m][n][j] * (sa * sg[n][j]), up = (float)acc[ai][1][m][n][j] * (sa * su[n][j]);
                        o[4 * n + j] = __builtin_amdgcn_fmed3f(g * sigmoid_f(g) * up * ACT_Q, -448.0f, 448.0f); }
                int w0 = 0, w1 = 0; w0 = __builtin_amdgcn_cvt_pk_fp8_f32(o[0], o[1], w0, false); w0 = __builtin_amdgcn_cvt_pk_fp8_f32(o[2], o[3], w0, true); w1 = __builtin_amdgcn_cvt_pk_fp8_f32(o[4], o[5], w1, false); w1 = __builtin_amdgcn_cvt_pk_fp8_f32(o[6], o[7], w1, true);
                u32x2 w; w.x = (unsigned)w0; w.y = (unsigned)w1; *(u32x2*)(O + (size_t)r * ldc + col0) = w; }
    }
};
struct EpiF32 {
    static constexpr bool PERM = false, AFTER_DRAIN = false;
    float* C; int ldc;
    __device__ __forceinline__ void operator()(const f32x4 (&acc)[2][2][4][2], const Unit& u, int wr, int wc, int fr, int fq) const {
        const int row0 = u.pm * BM + wr * 64 + fr, col0 = u.pn * BM + wc * 32 + 4 * fq;
#pragma unroll
        for (int ai = 0; ai < 2; ++ai)
#pragma unroll
            for (int m = 0; m < 4; ++m) { float* rowp = C + (size_t)(row0 + ai * HALF + m * 16) * ldc + col0;
#pragma unroll
                for (int bj = 0; bj < 2; ++bj)
#pragma unroll
                    for (int n = 0; n < 2; ++n) *(f32x4*)(rowp + bj * HALF + n * 16) = acc[ai][bj][m][n]; }
    }
};
struct EpiBf16P {
    static constexpr bool PERM = true, AFTER_DRAIN = false;
    bf16_t* O; int ldc;
    __device__ __forceinline__ void operator()(const f32x4 (&acc)[2][2][4][2], const Unit& u, int wr, int wc, int fr, int fq) const {
        const int row0 = u.pm * BM + wr * 64 + fr, col0 = u.pn * BM + wc * 32 + 8 * fq;
#pragma unroll
        for (int ai = 0; ai < 2; ++ai)
#pragma unroll
            for (int m = 0; m < 4; ++m) { bf16_t* rowp = O + (size_t)(row0 + ai * HALF + m * 16) * ldc + col0;
#pragma unroll
                for (int bj = 0; bj < 2; ++bj) { const f32x4 v0 = acc[ai][bj][m][0], v1 = acc[ai][bj][m][1];
                    u32x4 w; w.x = cvt_pk_bf16(v0[0], v0[1]); w.y = cvt_pk_bf16(v0[2], v0[3]); w.z = cvt_pk_bf16(v1[0], v1[1]); w.w = cvt_pk_bf16(v1[2], v1[3]);
                    *(u32x4*)(rowp + bj * HALF) = w; } }
    }
};
struct EpiI8Bf16P {
    static constexpr bool PERM = true, AFTER_DRAIN = false;
    bf16_t* O; int ldc; const float* sA; const float* sW; int split, add;
    __device__ __forceinline__ void operator()(const i32x4 (&acc)[2][2][4][2], const Unit& u, int wr, int wc, int fr, int fq) const {
        const int row0 = u.pm * BM + wr * 64 + fr, col0 = u.pn * BM + wc * 32 + 8 * fq, ocol0 = (u.pn < split ? u.pn : u.pn + add) * BM + wc * 32 + 8 * fq;
        f32x4 sw[2][2];
#pragma unroll
        for (int bj = 0; bj < 2; ++bj)
#pragma unroll
            for (int n = 0; n < 2; ++n) sw[bj][n] = *(const f32x4*)(sW + col0 + bj * HALF + 4 * n);
#pragma unroll
        for (int ai = 0; ai < 2; ++ai)
#pragma unroll
            for (int m = 0; m < 4; ++m) { const int r = row0 + ai * HALF + m * 16; const float sa = sA[r]; bf16_t* rowp = O + (size_t)r * ldc + ocol0;
#pragma unroll
                for (int bj = 0; bj < 2; ++bj) { const i32x4 v0 = acc[ai][bj][m][0], v1 = acc[ai][bj][m][1]; const f32x4 s0 = sw[bj][0] * sa, s1 = sw[bj][1] * sa;
                    u32x4 w; w.x = cvt_pk_bf16((float)v0[0] * s0[0], (float)v0[1] * s0[1]); w.y = cvt_pk_bf16((float)v0[2] * s0[2], (float)v0[3] * s0[3]);
                    w.z = cvt_pk_bf16((float)v1[0] * s1[0], (float)v1[1] * s1[1]); w.w = cvt_pk_bf16((float)v1[2] * s1[2], (float)v1[3] * s1[3]);
                    *(u32x4*)(rowp + bj * HALF) = w; } }
    }
};
struct EpiGlu {
    static constexpr bool PERM = true, AFTER_DRAIN = false;
    const bf16_t* Y; int ldy; const float* bias; bf16_t* O; int ldc; int ocol0;
    __device__ __forceinline__ void operator()(const f32x4 (&acc)[2][2][4][2], const Unit& u, int wr, int wc, int fr, int fq) const {
        const int row0 = u.pm * BM + wr * 64 + fr, col0 = u.pn * BM + wc * 32 + 8 * fq;
        f32x4 bv[2][2];
#pragma unroll
        for (int bj = 0; bj < 2; ++bj)
#pragma unroll
            for (int n = 0; n < 2; ++n) bv[bj][n] = *(const f32x4*)(bias + col0 + bj * HALF + 4 * n);
#pragma unroll
        for (int ai = 0; ai < 2; ++ai)
#pragma unroll
            for (int m = 0; m < 4; ++m) { const size_t r = (size_t)(row0 + ai * HALF + m * 16);
#pragma unroll
                for (int bj = 0; bj < 2; ++bj) { const u32x4 yv = *(const u32x4*)(Y + r * ldy + col0 + bj * HALF);
                    const f32x4 z0 = acc[ai][bj][m][0] + bv[bj][0], z1 = acc[ai][bj][m][1] + bv[bj][1];
                    float o[8];
                    o[0] = __uint_as_float(yv.x << 16) * sigmoid_f(z0[0]); o[1] = __uint_as_float(yv.x & 0xffff0000u) * sigmoid_f(z0[1]);
                    o[2] = __uint_as_float(yv.y << 16) * sigmoid_f(z0[2]); o[3] = __uint_as_float(yv.y & 0xffff0000u) * sigmoid_f(z0[3]);
                    o[4] = __uint_as_float(yv.z << 16) * sigmoid_f(z1[0]); o[5] = __uint_as_float(yv.z & 0xffff0000u) * sigmoid_f(z1[1]);
                    o[6] = __uint_as_float(yv.w << 16) * sigmoid_f(z1[2]); o[7] = __uint_as_float(yv.w & 0xffff0000u) * sigmoid_f(z1[3]);
                    u32x4 w; w.x = cvt_pk_bf16(o[0], o[1]); w.y = cvt_pk_bf16(o[2], o[3]); w.z = cvt_pk_bf16(o[4], o[5]); w.w = cvt_pk_bf16(o[6], o[7]);
                    *(u32x4*)(O + r * ldc + ocol0 + col0 + bj * HALF) = w; } }
    }
};
template <class Epi, class Sched, bool ALIGN_EPI = false, bool SP2 = false, int QT = 0>
__device__ __forceinline__ void gemm_phase(PG8_LAS unsigned char* lds, const Gemm g, const Sched& S, const Epi& E, int wid_in, int sw = 127, int sa = 127) {
    const int wid = wid_in, lane = lane_now(), tid = wid * 64 + lane, wr = wid >> 2, wc = wid & 3, fr = lane & 15, fq = lane >> 4;
    const int K = g.K, nt = K / BK;
    unsigned voffA[2], voffB[2];
#pragma unroll
    for (int i = 0; i < 2; ++i) { int R, C; stage_rc(tid * 16 + i * 8192, R, C); const int Rb = Epi::PERM ? ((R & ~31) + perm32(R & 31)) : R;
        voffA[i] = (unsigned)(R * K + C) * 2u; voffB[i] = (unsigned)(Rb * K + C) * 2u; }
    const unsigned kstep = (unsigned)(BK * 2);
    const unsigned hstep = (unsigned)HALF * (unsigned)K * 2u;
    const unsigned tstep = 2u * hstep;
    const unsigned ldsw = (unsigned)wid * 1024u;
    const int aoff = lds_byte(wr * 64 + fr, fq * 8), boff = lds_byte(wc * 32 + fr, fq * 8);
#define PG8_SA(b, h) (((b) * 2 + (h)) * HTB)
#define PG8_SB(b, h) ((4 + (b) * 2 + (h)) * HTB)
    const __amdgpu_buffer_rsrc_t rsrc_voffA = __builtin_amdgcn_make_buffer_rsrc((void*)g.A, 0, (int)((unsigned)g.M * (unsigned)K * 2u), 0x00020000);
    const __amdgpu_buffer_rsrc_t rsrc_voffB = __builtin_amdgcn_make_buffer_rsrc((void*)g.Bt, 0, (int)((unsigned)g.N * (unsigned)K * 2u), 0x00020000);
#define PG8_STAGE(bufoff, goff, voff) do { _Pragma("unroll") for (int _i = 0; _i < 2; ++_i) \
        __builtin_amdgcn_raw_ptr_buffer_load_lds(rsrc_##voff, (PG8_LAS void*)(lds + (bufoff) + ldsw + _i * 8192), 16, (int)(voff)[_i], (int)(goff), 0, 0); } while (0)
#define PG8_LDA(dst, b, h) do { _Pragma("unroll") for (int m = 0; m < 4; ++m) _Pragma("unroll") for (int k = 0; k < 2; ++k) dst[m][k] = *(const PG8_LAS bf16x8*)(lds + PG8_SA(b, h) + aoff + m * 2048 + k * 1024); } while (0)
#define PG8_LDB(dst, b, h) do { _Pragma("unroll") for (int n = 0; n < 2; ++n) _Pragma("unroll") for (int k = 0; k < 2; ++k) dst[n][k] = *(const PG8_LAS bf16x8*)(lds + PG8_SB(b, h) + boff + n * 2048 + k * 1024); } while (0)
#define PG8_MMA(ai, bj, At, Bt) do { __builtin_amdgcn_s_setprio(1); _Pragma("unroll") for (int m = 0; m < 4; ++m) _Pragma("unroll") for (int n = 0; n < 2; ++n) { \
        if constexpr (QT == 1) acc[ai][bj][m][n] = __builtin_amdgcn_mfma_scale_f32_16x16x128_f8f6f4(cat8(Bt[n][0], Bt[n][1]), cat8(At[m][0], At[m][1]), acc[ai][bj][m][n], 0, 0, 0, sw, 0, sa); \
        else if constexpr (QT == 2) { _Pragma("unroll") for (int k = 0; k < 2; ++k) acc[ai][bj][m][n] = __builtin_amdgcn_mfma_i32_16x16x64_i8(__builtin_bit_cast(i32x4, Bt[n][k]), __builtin_bit_cast(i32x4, At[m][k]), acc[ai][bj][m][n], 0, 0, 0); } \
        else { _Pragma("unroll") for (int k = 0; k < 2; ++k) acc[ai][bj][m][n] = __builtin_amdgcn_mfma_f32_16x16x32_bf16(Bt[n][k], At[m][k], acc[ai][bj][m][n], 0, 0, 0); } } __builtin_amdgcn_s_setprio(0); } while (0)
#define PG8_WAIT_V(n) asm volatile("s_waitcnt vmcnt(" #n ")" ::: "memory")
#define PG8_WAIT_L(n) asm volatile("s_waitcnt lgkmcnt(" #n ")" ::: "memory")
#define PG8_BAR __builtin_amdgcn_s_barrier()
#define PG8_SCHED __builtin_amdgcn_sched_barrier(0)
    Unit cur, nxt; int ui = 0;
    if (!S.next(0, cur)) return;
    typedef typename AccOf<QT>::type acc_t;
    acc_t acc[2][2][4][2];
#pragma unroll
    for (int a = 0; a < 2; ++a)
#pragma unroll
        for (int b = 0; b < 2; ++b)
#pragma unroll
            for (int m = 0; m < 4; ++m)
#pragma unroll
                for (int n = 0; n < 2; ++n) acc[a][b][m][n] = acc_t{};
    bf16x8 At[4][2], B0[2][2], B1[2][2];
    unsigned cA = (unsigned)cur.pm * tstep, cB = (unsigned)cur.pn * tstep;
    S.a_ready(cur);
    if constexpr (SP2) {
        PG8_STAGE(PG8_SB(0, 0), cB, voffB); PG8_STAGE(PG8_SB(0, 1), cB + hstep, voffB); PG8_STAGE(PG8_SA(0, 0), cA, voffA); PG8_STAGE(PG8_SA(0, 1), cA + hstep, voffA);
        if (wr == 1) PG8_BAR;
        PG8_WAIT_V(2); PG8_BAR;
        PG8_STAGE(PG8_SB(1, 0), cB + kstep, voffB); PG8_STAGE(PG8_SA(1, 0), cA + kstep, voffA); PG8_STAGE(PG8_SB(1, 1), cB + hstep + kstep, voffB);
        PG8_WAIT_V(6); PG8_BAR;
    } else {
        PG8_STAGE(PG8_SB(0, 0), cB, voffB); PG8_STAGE(PG8_SA(0, 0), cA, voffA); PG8_STAGE(PG8_SB(0, 1), cB + hstep, voffB); PG8_STAGE(PG8_SA(0, 1), cA + hstep, voffA);
        if (wr == 1) PG8_BAR;
        PG8_WAIT_V(4); PG8_BAR;
        PG8_STAGE(PG8_SB(1, 0), cB + kstep, voffB); PG8_STAGE(PG8_SA(1, 0), cA + kstep, voffA); PG8_STAGE(PG8_SB(1, 1), cB + hstep + kstep, voffB);
        PG8_WAIT_V(6); PG8_BAR;
    }
    for (;;) {
        const bool has_next = S.next(ui + 1, nxt);
        const unsigned nA = has_next ? (unsigned)nxt.pm * tstep : cA, nB = has_next ? (unsigned)nxt.pn * tstep : cB;
        for (int t = 0; t < nt; t += 2) {
            const bool last = (t == nt - 2);
            const unsigned a1 = cA + (unsigned)(t + 1) * kstep;
            const unsigned a2 = last ? nA : cA + (unsigned)(t + 2) * kstep, b2 = last ? nB : cB + (unsigned)(t + 2) * kstep;
            const unsigned a3 = a2 + kstep, b3 = b2 + kstep;
            if (last && has_next) S.a_ready(nxt);
            if constexpr (SP2) {
            PG8_LDB(B0, 0, 0); PG8_LDB(B1, 0, 1); PG8_SCHED; PG8_LDA(At, 0, 0); PG8_STAGE(PG8_SA(1, 1), a1 + hstep, voffA);
            PG8_WAIT_V(8); PG8_WAIT_L(0); PG8_BAR; PG8_MMA(0, 0, At, B0); PG8_MMA(0, 1, At, B1); PG8_BAR; PG8_SCHED;
            PG8_LDA(At, 0, 1); PG8_STAGE(PG8_SB(0, 0), b2, voffB); PG8_STAGE(PG8_SB(0, 1), b2 + hstep, voffB); PG8_STAGE(PG8_SA(0, 0), a2, voffA);
            PG8_WAIT_V(8); PG8_WAIT_L(0); PG8_BAR; PG8_MMA(1, 0, At, B0); PG8_MMA(1, 1, At, B1); PG8_BAR; PG8_SCHED;
            PG8_LDB(B0, 1, 0); PG8_LDB(B1, 1, 1); PG8_SCHED; PG8_LDA(At, 1, 0); PG8_STAGE(PG8_SA(0, 1), a2 + hstep, voffA);
            PG8_WAIT_V(8); PG8_WAIT_L(0); PG8_BAR; PG8_MMA(0, 0, At, B0); PG8_MMA(0, 1, At, B1); PG8_BAR; PG8_SCHED;
            PG8_LDA(At, 1, 1); PG8_STAGE(PG8_SB(1, 0), b3, voffB); PG8_STAGE(PG8_SB(1, 1), b3 + hstep, voffB); PG8_STAGE(PG8_SA(1, 0), a3, voffA);
            PG8_WAIT_V(8); PG8_WAIT_L(0); PG8_BAR; PG8_MMA(1, 0, At, B0); PG8_MMA(1, 1, At, B1); PG8_BAR; PG8_SCHED;
            } else {
            PG8_LDB(B0, 0, 0); PG8_SCHED; PG8_LDA(At, 0, 0); PG8_STAGE(PG8_SA(1, 1), a1 + hstep, voffA);
            PG8_WAIT_L(8); PG8_BAR; PG8_WAIT_L(0); PG8_MMA(0, 0, At, B0); PG8_BAR; PG8_SCHED;
            PG8_LDB(B1, 0, 1); PG8_STAGE(PG8_SB(0, 0), b2, voffB);
            PG8_BAR; PG8_WAIT_L(0); PG8_MMA(0, 1, At, B1); PG8_BAR;
            PG8_LDA(At, 0, 1); PG8_STAGE(PG8_SA(0, 0), a2, voffA);
            PG8_BAR; PG8_WAIT_L(0); PG8_MMA(1, 0, At, B0); PG8_BAR; PG8_SCHED;
            PG8_STAGE(PG8_SB(0, 1), b2 + hstep, voffB);
            PG8_WAIT_V(6); PG8_BAR; PG8_MMA(1, 1, At, B1); PG8_BAR;
            PG8_LDB(B0, 1, 0); PG8_SCHED; PG8_LDA(At, 1, 0); PG8_STAGE(PG8_SA(0, 1), a2 + hstep, voffA);
            PG8_WAIT_L(8); PG8_BAR; PG8_WAIT_L(0); PG8_MMA(0, 0, At, B0); PG8_BAR; PG8_SCHED;
            PG8_LDB(B1, 1, 1); PG8_STAGE(PG8_SB(1, 0), b3, voffB);
            PG8_BAR; PG8_WAIT_L(0); PG8_MMA(0, 1, At, B1); PG8_BAR;
            PG8_LDA(At, 1, 1); PG8_STAGE(PG8_SA(1, 0), a3, voffA);
            PG8_BAR; PG8_WAIT_L(0); PG8_MMA(1, 0, At, B0); PG8_BAR; PG8_SCHED;
            PG8_STAGE(PG8_SB(1, 1), b3 + hstep, voffB);
            PG8_WAIT_V(6); PG8_BAR; PG8_MMA(1, 1, At, B1); PG8_BAR;
            }
        }
        if constexpr (ALIGN_EPI) { if (wr == 0) PG8_BAR; }
        if constexpr (!Epi::AFTER_DRAIN) { E(acc, cur, wr, wc, fr, fq); S.done(cur); }
        if (!has_next) break;
#pragma unroll
        for (int a = 0; a < 2; ++a)
#pragma unroll
            for (int b = 0; b < 2; ++b)
#pragma unroll
                for (int m = 0; m < 4; ++m)
#pragma unroll
                    for (int n = 0; n < 2; ++n) acc[a][b][m][n] = acc_t{};
        cur = nxt; cA = nA; cB = nB; ++ui;
        if constexpr (ALIGN_EPI) { if (wr == 1) PG8_BAR; }
    }
    PG8_WAIT_V(0);
    if constexpr (!ALIGN_EPI) { if (wr == 0) PG8_BAR; }
    PG8_BAR;
    if constexpr (Epi::AFTER_DRAIN) { E.fused(acc, cur, wr, wc, fr, fq, lds, wid, lane); S.done(cur); }
#undef PG8_SA
#undef PG8_SB
#undef PG8_STAGE
#undef PG8_LDA
#undef PG8_LDB
#undef PG8_MMA
#undef PG8_WAIT_V
#undef PG8_WAIT_L
#undef PG8_BAR
#undef PG8_SCHED
}
}

constexpr int NWAVES = 8;
constexpr int D = 4096, M = 8192, MP = 4096, DFF = 11008, NGU = 2 * DFF, NIN = 8192, SW = 2048;
constexpr int NMODC = 9 * D;
constexpr int D_IN_SRC = 8224;
constexpr float EPS = 1e-6f;
constexpr int NPH = 14;
#ifndef MK_FP8
#define MK_FP8 1
#endif
#ifndef MK_PER_PHASE
#define MK_PER_PHASE 0
#endif
constexpr int PJ_Q = 0, PJ_K = 1024, PJ_V = 2048, PJ_G = 4096, PJ_U = 6144;
constexpr size_t OUT_Y = 0, OUT_GLA = (size_t)M * D, OUT_S5R = OUT_GLA + (size_t)16 * 2 * 8 * 128 * 256, OUT_S5I = OUT_S5R + 16 * 2 * 128 * 64, OUT_END = OUT_S5I + 16 * 2 * 128 * 64;
constexpr size_t MiB = 1u << 20;
constexpr size_t WS_CTL = 0, CTL_ZERO_BYTES = 1 * MiB;
constexpr size_t WS_WGU1 = 1 * MiB;
constexpr size_t WS_WDN1 = WS_WGU1 + 172 * MiB;
constexpr size_t WS_WIN = WS_WDN1 + 86 * MiB;
constexpr size_t WS_WLR = WS_WIN + 64 * MiB;
constexpr size_t WS_WGLU = WS_WLR + 1 * MiB;
constexpr size_t WS_WOUT = WS_WGLU + 8 * MiB;
constexpr size_t WS_WGU2 = WS_WOUT + 32 * MiB;
constexpr size_t WS_WDN2 = WS_WGU2 + 172 * MiB;
constexpr size_t WS_S5B1 = WS_WDN2 + 86 * MiB;
constexpr size_t WS_S5B2 = WS_S5B1 + 32 * MiB;
constexpr size_t WS_MOD = WS_S5B2 + 16 * MiB;
constexpr size_t WS_ROPE = WS_MOD + 1 * MiB;
constexpr size_t WS_A16 = WS_ROPE + 65536;
constexpr size_t WS_SA = WS_ROPE + 262144;
constexpr size_t WS_SW = WS_ROPE + 327680;
constexpr size_t WS_H = WS_ROPE + 1 * MiB;
constexpr size_t WS_ACT = WS_H + 64 * MiB;
constexpr size_t WS_FFO = WS_ACT + 172 * MiB;
constexpr size_t WS_X1 = WS_FFO + 128 * MiB;
constexpr size_t WS_PROJ = WS_X1 + 128 * MiB;
constexpr size_t WS_LR = WS_PROJ + 128 * MiB;
constexpr size_t WS_OF = WS_LR + 1 * MiB;
constexpr size_t WS_OB = WS_OF + 64 * MiB;
constexpr size_t WS_YS5 = WS_OB + 64 * MiB;
constexpr size_t WS_CAT = WS_YS5 + 32 * MiB;
constexpr size_t WS_GLAW = WS_CAT + 64 * MiB;
constexpr size_t WS_VTW = WS_GLAW + 90 * MiB;
constexpr size_t WS_MODP = WS_VTW + 36 * MiB;
constexpr size_t WS_END = WS_MODP + 2 * MiB;
static_assert((size_t)NGU * D * 2 <= 172 * MiB && (size_t)D * DFF * 2 <= 86 * MiB && (size_t)M * DFF * 2 <= 172 * MiB, "ws map");
constexpr int CW_TMO = 0, CW_QUEUE = 1024, CW_BAR = 4096;
constexpr int LDS_BYTES = 163840;
constexpr int MISC_OFF = LDS_BYTES - 128;
constexpr int RING_OFF = 0;

#define GAS __attribute__((address_space(1)))
#define LAS __attribute__((address_space(3)))
typedef unsigned short bf16;
typedef unsigned v4u __attribute__((ext_vector_type(4)));
typedef unsigned v2u __attribute__((ext_vector_type(2)));
typedef float f32x4 __attribute__((ext_vector_type(4)));
typedef float f32x2 __attribute__((ext_vector_type(2)));
typedef float f32x16 __attribute__((ext_vector_type(16)));
typedef short bf16x8 __attribute__((ext_vector_type(8)));
typedef GAS unsigned gu32;
#define RLX_AGENT __ATOMIC_RELAXED, __HIP_MEMORY_SCOPE_AGENT
#define LDS_WAIT() asm volatile("s_waitcnt lgkmcnt(0)" ::: "memory")
#define VM_WAIT() asm volatile("s_waitcnt vmcnt(0)" ::: "memory")
typedef __bf16 hbf16x2 __attribute__((ext_vector_type(2)));
__device__ __forceinline__ unsigned pk2(float lo, float hi) { const f32x2 v = {lo, hi}; return __builtin_bit_cast(unsigned, __builtin_convertvector(v, hbf16x2)); }
__device__ __forceinline__ unsigned f2bf(float f) { return (unsigned)__builtin_bit_cast(unsigned short, (__bf16)f); }
__device__ __forceinline__ float bf2f(unsigned short b) { return __uint_as_float(((unsigned)b) << 16); }
__device__ __forceinline__ float bflo(unsigned w) { return __uint_as_float(w << 16); }
__device__ __forceinline__ float bfhi(unsigned w) { return __uint_as_float(w & 0xffff0000u); }
__device__ __forceinline__ float wave_sum(float v) {
#pragma unroll
    for (int o = 1; o < 64; o <<= 1) v += __shfl_xor(v, o);
    return v;
}
#define XB_TMO      128
#define XB_XCNT(j)  (256  + 64 * (j))
#define XB_XSUB(j)  (1280 + 64 * (j))
#define XB_XGEN(j)  (2304 + 64 * (j))
#define XB_TOP      3328
#define XB_TOPGEN   3392
#define XCD_BAR_WORDS 3456
#define XB_SPIN_CAP (1u << 18)

__device__ __forceinline__ unsigned xb_ld(unsigned* p)              { return __hip_atomic_load(p, __ATOMIC_RELAXED, __HIP_MEMORY_SCOPE_AGENT); }
__device__ __forceinline__ unsigned xb_add(unsigned* p, unsigned v) { return __hip_atomic_fetch_add(p, v, __ATOMIC_RELAXED, __HIP_MEMORY_SCOPE_AGENT); }
__device__ __forceinline__ unsigned xb_xcc_id() { return (unsigned)__builtin_amdgcn_s_getreg((3 << 11) | 20) & 0xFu; }
#define XB_SPIN(cond, bar) do { unsigned _sp = 0; while (cond) { __builtin_amdgcn_s_sleep(1); \
    if ((++_sp & 255u) == 0u) { if (xb_ld(&(bar)[XB_TMO])) break; if (_sp > XB_SPIN_CAP) { atomicAdd(&(bar)[XB_TMO], 1u); break; } } } } while (0)

struct XcdBarrier {
    unsigned* bar; unsigned x;
    volatile LAS unsigned* st;
};

__device__ __forceinline__ XcdBarrier xcd_barrier_post(unsigned* bar, volatile LAS unsigned* st) {
    XcdBarrier b; b.bar = bar; b.x = xb_xcc_id(); b.st = st;
    if (threadIdx.x == 0) (void)xb_add(&bar[XB_XCNT(b.x)], 1u);
    return b;
}
__device__ __forceinline__ void xcd_barrier_complete(unsigned* bar, unsigned x, unsigned& nloc, unsigned& nx) {
    const unsigned G = gridDim.x * gridDim.y * gridDim.z;
    unsigned sum, cnt, mine, sp = 0u;
    for (;;) {
        sum = 0u; cnt = 0u; mine = 0u;
#pragma unroll
        for (unsigned j = 0; j < 16; ++j) { const unsigned c = xb_ld(&bar[XB_XCNT(j)]); sum += c; cnt += (c > 0u) ? 1u : 0u; mine = (j == x) ? c : mine; }
        if (sum == G) break;
        __builtin_amdgcn_s_sleep(1);
        if ((++sp & 255u) == 0u) { if (xb_ld(&bar[XB_TMO])) break; if (sp > XB_SPIN_CAP) { atomicAdd(&bar[XB_TMO], 1u); break; } }
    }
    nloc = mine > 0u ? mine : 1u; nx = cnt > 0u ? cnt : 1u;
}

__device__ __forceinline__ void xcd_barrier(const XcdBarrier& b) {
    asm volatile("s_waitcnt vmcnt(0)" ::: "memory");
    __syncthreads();
    if (threadIdx.x == 0) {
        unsigned* bar = b.bar;
        __builtin_amdgcn_s_waitcnt(0);
        unsigned nloc = b.st[0], nx = b.st[1];
        if (nloc == 0u) { xcd_barrier_complete(bar, b.x, nloc, nx); b.st[0] = nloc; b.st[1] = nx; }
        const unsigned old = xb_add(&bar[XB_XSUB(b.x)], 1u);
        const unsigned gen = old / nloc;
        if (old + 1u == (gen + 1u) * nloc) {
            __builtin_amdgcn_fence(__ATOMIC_RELEASE, "agent");
            asm volatile("s_waitcnt vmcnt(0)" ::: "memory");
            const unsigned og = xb_add(&bar[XB_TOP], 1u);
            const unsigned tg = og / nx;
            if (og + 1u == (tg + 1u) * nx) xb_add(&bar[XB_TOPGEN], 1u);
            else XB_SPIN(xb_ld(&bar[XB_TOPGEN]) == tg, bar);
            __builtin_amdgcn_fence(__ATOMIC_ACQUIRE, "agent");
            xb_add(&bar[XB_XGEN(b.x)], 1u);
            asm volatile("s_waitcnt vmcnt(0)" ::: "memory");
        } else {
            XB_SPIN(xb_ld(&bar[XB_XGEN(b.x)]) == gen, bar);
            __builtin_amdgcn_fence(__ATOMIC_ACQUIRE, "agent");
            asm volatile("s_waitcnt vmcnt(0)" ::: "memory");
        }
    }
    __syncthreads();
}

struct Frame {
    LAS unsigned char* lds;
    volatile LAS unsigned* MISC;
    gu32* ctl;
    int tid, lane, wave;
    int vcu, G;
    float* out;
    unsigned char* ws;
};
constexpr int PTR_OFF = LDS_BYTES - 512;
__device__ __forceinline__ const float* inp(const Frame& F, int i) { const v2u p = *(const LAS v2u*)(F.lds + PTR_OFF + 8 * i);
    const unsigned long long a = ((unsigned long long)(unsigned)__builtin_amdgcn_readfirstlane((int)p.y) << 32) | (unsigned)__builtin_amdgcn_readfirstlane((int)p.x); return (const float*)a; }
#define IN_XP 0
#define IN_XS 1
#define IN_C 2
#define IN_SGLA 3
#define IN_SS5R 4
#define IN_SS5I 5
#define IN_CCTX 6
#define IN_WADA 7
#define IN_BADA 8
#define IN_NORMW 9
#define IN_WGU1 10
#define IN_WDN1 11
#define IN_WIN 12
#define IN_WGATE 13
#define IN_BGATE 14
#define IN_GNW 15
#define IN_LAMR 16
#define IN_LAMI 17
#define IN_LOGDT 18
#define IN_BRE 19
#define IN_BIM 20
#define IN_CRE 21
#define IN_CIM 22
#define IN_DSKIP 23
#define IN_WGLU 24
#define IN_BGLU 25
#define IN_WOUT 26
#define IN_WGU2 27
#define IN_WDN2 28
__device__ __forceinline__ const float* xrow(const Frame& F, int m) { return m < MP ? inp(F, IN_XP) + (size_t)m * D : inp(F, IN_XS) + (size_t)(m - MP) * D; }
__device__ __forceinline__ int mod_idx(int m) { return m < MP ? 0 : 1 + ((m - MP) >> 11); }

struct TrDesc { const float* src; unsigned char* dst; int ldw, K; bool valid, fp8; };
constexpr int TR_I_GU = 64 * 344, TR_I_DN = 172 * 64, TR_I_IN = 64 * 129, TR_I_GLU = 32 * 32, TR_I_OUT = 64 * 64;
constexpr int TR_NITEMS = 2 * TR_I_DN + TR_I_IN + TR_I_GLU;
__device__ __forceinline__ TrDesc tr_decode(const Frame& F, int it, int lane) {
    TrDesc d; d.valid = false; d.fp8 = false; d.src = nullptr; d.dst = nullptr; d.ldw = 0; d.K = 0;
    if (it >= TR_NITEMS) return d;
    int r = it, src_col, dst_row, k0, nvalid = 64, K, ldw; const float* W; bf16* WT; bool fp8 = false;
    if (r < 2 * TR_I_DN) { const int which = r >= TR_I_DN; if (which) r -= TR_I_DN; const int nb = r & 63, kb = r >> 6;
        src_col = 64 * nb; dst_row = 64 * nb; k0 = 64 * kb; K = DFF; ldw = D; W = inp(F, which ? IN_WDN2 : IN_WDN1); WT = (bf16*)(F.ws + (which ? WS_WDN2 : WS_WDN1)); fp8 = true; }
    else if ((r -= 2 * TR_I_DN) < TR_I_IN) { const int nb = r % 129, kb = r / 129; k0 = 64 * kb; K = D; ldw = D_IN_SRC; W = inp(F, IN_WIN);
        if (nb < 96) { src_col = 64 * nb; dst_row = 64 * nb; WT = (bf16*)(F.ws + WS_WIN); if (nb < 16 || nb >= 64) nvalid = 0; }
        else if (nb < 128) { src_col = 6176 + 64 * (nb - 96); dst_row = 64 * nb; WT = (bf16*)(F.ws + WS_WIN); }
        else { src_col = 6144; dst_row = 0; WT = (bf16*)(F.ws + WS_WLR); nvalid = 32; } }
    else if ((r -= TR_I_IN) < TR_I_GLU) { const int nb = r & 31, kb = r >> 5; src_col = 64 * nb; dst_row = 64 * nb; k0 = 64 * kb; K = SW; ldw = SW; W = inp(F, IN_WGLU); WT = (bf16*)(F.ws + WS_WGLU); fp8 = true; }
    else { r -= TR_I_GLU; const int nb = r & 63, kb = r >> 6; src_col = 64 * nb; dst_row = 64 * nb; k0 = 64 * kb; K = D; ldw = D; W = inp(F, IN_WOUT); WT = (bf16*)(F.ws + WS_WOUT); }
    d.ldw = ldw; d.fp8 = fp8;
    if (fp8) { const int kc = lane & 3, nq = lane >> 2; d.valid = true; d.K = K;
        d.src = W + (size_t)(k0 + 16 * kc) * ldw + src_col + 4 * nq; d.dst = (unsigned char*)WT + (size_t)(dst_row + 4 * nq) * K + k0 + 16 * kc; }
    else { const int kc = lane & 7, nq = lane >> 3; d.valid = 8 * nq < nvalid; d.K = 2 * K;
        d.src = W + (size_t)(k0 + 8 * kc) * ldw + src_col + 8 * nq; d.dst = (unsigned char*)(WT + (size_t)(dst_row + 8 * nq) * K + k0 + 8 * kc); }
    return d;
}
constexpr float WDN_Q = 1024.0f;
__device__ __forceinline__ float q8(float w) { return __builtin_amdgcn_fmed3f(w * WDN_Q, -448.0f, 448.0f); }
__device__ __forceinline__ void tr_load(const TrDesc& d, f32x4 (&a)[16]) {
    if (d.valid) {
        if (d.fp8) {
#pragma unroll
            for (int i = 0; i < 16; ++i) a[i] = *(const GAS f32x4*)(d.src + (size_t)i * d.ldw);
        } else {
#pragma unroll
            for (int i = 0; i < 8; ++i) { a[2 * i] = *(const GAS f32x4*)(d.src + (size_t)i * d.ldw); a[2 * i + 1] = *(const GAS f32x4*)(d.src + (size_t)i * d.ldw + 4); }
        }
    }
}
__device__ __forceinline__ void tr_store(const TrDesc& d, const f32x4 (&a)[16]) {
    if (d.valid) {
        if (d.fp8) {
#pragma unroll
            for (int j = 0; j < 4; ++j) { int w[4];
#pragma unroll
                for (int t = 0; t < 4; ++t) { int x = 0; x = __builtin_amdgcn_cvt_pk_fp8_f32(q8(a[4 * t][j]), q8(a[4 * t + 1][j]), x, false); x = __builtin_amdgcn_cvt_pk_fp8_f32(q8(a[4 * t + 2][j]), q8(a[4 * t + 3][j]), x, true); w[t] = x; }
                v4u o; o.x = (unsigned)w[0]; o.y = (unsigned)w[1]; o.z = (unsigned)w[2]; o.w = (unsigned)w[3];
                *(GAS v4u*)(d.dst + (size_t)j * d.K) = o; }
        } else {
#pragma unroll
            for (int j = 0; j < 8; ++j) { const int h = j >> 2, e = j & 3; v4u o; o.x = pk2(a[0 + h][e], a[2 + h][e]); o.y = pk2(a[4 + h][e], a[6 + h][e]); o.z = pk2(a[8 + h][e], a[10 + h][e]); o.w = pk2(a[12 + h][e], a[14 + h][e]);
                *(GAS v4u*)(d.dst + (size_t)j * d.K) = o; }
        }
    }
}
__device__ __forceinline__ void s5_prep(Frame& F, int g) {
    LAS float* T = (LAS float*)(F.lds + 49152);
    LAS float* APR = T;
    LAS float* API = APR + 2 * 17 * 64;
    LAS float* BBR = API + 2 * 17 * 64;
    LAS float* BBI = BBR + 2048;
    LAS float* CR = BBI + 2048;
    LAS float* CI = CR + 2048;
    LAS float* FR = CI + 2048;
    LAS float* FI = FR + 128;
    LAS float* KF = FI + 128;
    LAS float* CTR = KF + 8192;
    LAS float* CTI = CTR + 2048;
    const int tid = F.tid;
    if (tid < 128) {
        const int dir = tid >> 6, p = tid & 63;
        const double lr = (double)inp(F, IN_LAMR)[(dir * 128 + g) * 64 + p], li = (double)inp(F, IN_LAMI)[(dir * 128 + g) * 64 + p];
        const double dt = exp((double)inp(F, IN_LOGDT)[dir * 128 + g]);
        const double mag = exp(lr * dt), ar = mag * cos(li * dt), ai = mag * sin(li * dt);
        const double den = lr * lr + li * li;
        FR[tid] = (float)(((ar - 1.0) * lr + ai * li) / den); FI[tid] = (float)((ai * lr - (ar - 1.0) * li) / den);
        double pr = 1.0, pi = 0.0;
        for (int t = 0; t <= 16; ++t) { APR[(dir * 17 + t) * 64 + p] = (float)pr; API[(dir * 17 + t) * 64 + p] = (float)pi;
            if (t == 16) { float* a16 = (float*)(F.ws + WS_A16) + ((g * 2 + dir) * 64 + p) * 2; a16[0] = (float)pr; a16[1] = (float)pi; }
            const double nr = pr * ar - pi * ai, ni = pr * ai + pi * ar; pr = nr; pi = ni; }
    } else {
        for (int i = tid - 128; i < 2048; i += 384) { const int dir = i >> 10, cc = (i >> 6) & 15, pp = i & 63;
            const float cr = inp(F, IN_CRE)[((dir * 128 + g) * 16 + cc) * 64 + pp], ci = inp(F, IN_CIM)[((dir * 128 + g) * 16 + cc) * 64 + pp];
            CR[i] = cr; CI[i] = ci; CTR[dir * 1024 + pp * 16 + cc] = cr; CTI[dir * 1024 + pp * 16 + cc] = ci; }
    }
    __syncthreads();
    for (int i = tid; i < 2048; i += 512) { const int dir = i >> 10, p = (i >> 4) & 63, c = i & 15;
        const float br = inp(F, IN_BRE)[((dir * 128 + g) * 64 + p) * 16 + c], bi = inp(F, IN_BIM)[((dir * 128 + g) * 64 + p) * 16 + c];
        const float fr = FR[dir * 64 + p], fi = FI[dir * 64 + p];
        BBR[i] = fr * br - fi * bi; BBI[i] = fr * bi + fi * br; }
    __syncthreads();
    { const int dir = tid >> 8, tau = (tid >> 4) & 15, cb = (tid >> 2) & 3, c2b = tid & 3;
        const LAS f32x4* ctr = (const LAS f32x4*)(CTR + dir * 1024) + cb; const LAS f32x4* cti = (const LAS f32x4*)(CTI + dir * 1024) + cb;
        const LAS f32x4* bbr = (const LAS f32x4*)(BBR + dir * 1024) + c2b; const LAS f32x4* bbi = (const LAS f32x4*)(BBI + dir * 1024) + c2b;
        const LAS float* pr = APR + (dir * 17 + tau) * 64; const LAS float* pi = API + (dir * 17 + tau) * 64;
        f32x4 k0 = {0.f, 0.f, 0.f, 0.f}, k1 = k0, k2 = k0, k3 = k0;
#pragma unroll 4
        for (int p = 0; p < 64; ++p) { const f32x4 cr = ctr[p * 4], ci = cti[p * 4], br = bbr[p * 4], bi = bbi[p * 4]; const float ar = pr[p], ai = pi[p];
            const f32x4 xr = cr * ar - ci * ai, xi = cr * ai + ci * ar;
            k0 += xr[0] * br - xi[0] * bi; k1 += xr[1] * br - xi[1] * bi; k2 += xr[2] * br - xi[2] * bi; k3 += xr[3] * br - xi[3] * bi; }
        LAS f32x4* ko = (LAS f32x4*)(KF + ((dir * 16 + tau) * 16 + 4 * cb) * 16) + c2b;
        ko[0] = k0; ko[4] = k1; ko[8] = k2; ko[12] = k3; }
    __syncthreads();
    bf16* B1 = (bf16*)(F.ws + WS_S5B1) + (size_t)g * 512 * 256; bf16* B2 = (bf16*)(F.ws + WS_S5B2) + (size_t)g * 256 * 256;
    const float* dsk = inp(F, IN_DSKIP) + g * 16;
    for (int id = tid; id < 8192; id += 512) { const int n = id >> 5, k8 = id & 31, t = n >> 4, c = n & 15, s = k8 >> 1, c0 = (k8 & 1) * 8; float v[8];
#pragma unroll
        for (int j = 0; j < 8; ++j) { const int c2 = c0 + j; float x = 0.f;
            if (s <= t) x += KF[((0 * 16 + (t - s)) * 16 + c) * 16 + c2];
            if (s >= t) x += KF[((1 * 16 + (s - t)) * 16 + c) * 16 + c2];
            if (s == t && c == c2) x += dsk[c];
            v[j] = x; }
        v4u o; o.x = pk2(v[0], v[1]); o.y = pk2(v[2], v[3]); o.z = pk2(v[4], v[5]); o.w = pk2(v[6], v[7]);
        *(GAS v4u*)(B1 + (size_t)n * 256 + k8 * 8) = o; }
    for (int id = tid; id < 8192; id += 512) { const int hc = id >> 5, k8 = id & 31, dir = hc >> 7, ri = (hc >> 6) & 1, p = hc & 63, s = k8 >> 1, c0 = (k8 & 1) * 8;
        const int e = dir ? s : 15 - s; const float er = APR[(dir * 17 + e) * 64 + p], ei = API[(dir * 17 + e) * 64 + p]; float v[8];
#pragma unroll
        for (int j = 0; j < 8; ++j) { const float br = BBR[dir * 1024 + p * 16 + c0 + j], bi = BBI[dir * 1024 + p * 16 + c0 + j]; v[j] = ri ? (er * bi + ei * br) : (er * br - ei * bi); }
        v4u o; o.x = pk2(v[0], v[1]); o.y = pk2(v[2], v[3]); o.z = pk2(v[4], v[5]); o.w = pk2(v[6], v[7]);
        *(GAS v4u*)(B1 + (size_t)(256 + hc) * 256 + k8 * 8) = o; }
    for (int id = tid; id < 8192; id += 512) { const int n = id >> 5, k8 = id & 31, t = n >> 4, c = n & 15, dir = k8 >> 4, ri = (k8 >> 3) & 1, p0 = (k8 & 7) * 8;
        const int e = dir ? 16 - t : t + 1; float v[8];
#pragma unroll
        for (int j = 0; j < 8; ++j) { const int p = p0 + j; const float er = APR[(dir * 17 + e) * 64 + p], ei = API[(dir * 17 + e) * 64 + p], cr = CR[(dir * 16 + c) * 64 + p], ci = CI[(dir * 16 + c) * 64 + p];
            v[j] = ri ? -(cr * ei + ci * er) : (cr * er - ci * ei); }
        v4u o; o.x = pk2(v[0], v[1]); o.y = pk2(v[2], v[3]); o.z = pk2(v[4], v[5]); o.w = pk2(v[6], v[7]);
        *(GAS v4u*)(B2 + (size_t)n * 256 + k8 * 8) = o; }
    __syncthreads();
}
__device__ __forceinline__ int qi8(float x) { return __float2int_rn(x) & 0xff; }
__device__ __forceinline__ void gu_slab_load(const float* src, int ldw, f32x4 (&a)[16]) {
#pragma unroll
    for (int i = 0; i < 16; ++i) a[i] = *(const GAS f32x4*)(src + (size_t)i * ldw);
}
__device__ __forceinline__ void gu_slab_store(unsigned char* dst, const f32x4 (&a)[16], const f32x4 inv) {
#pragma unroll
    for (int j = 0; j < 4; ++j) { unsigned w[4];
#pragma unroll
        for (int t = 0; t < 4; ++t) w[t] = (unsigned)qi8(a[4 * t][j] * inv[j]) | ((unsigned)qi8(a[4 * t + 1][j] * inv[j]) << 8) | ((unsigned)qi8(a[4 * t + 2][j] * inv[j]) << 16) | ((unsigned)qi8(a[4 * t + 3][j] * inv[j]) << 24);
        v4u o; o.x = w[0]; o.y = w[1]; o.z = w[2]; o.w = w[3];
        *(GAS v4u*)(dst + (size_t)j * D) = o; }
}
constexpr int GUC_WAVE = 16 * 1056, GUC_END = 8 * GUC_WAVE;
__device__ __forceinline__ void gu_slab_store_bf(unsigned char* dst, const v2u (&c)[16], const f32x4 inv) {
#pragma unroll
    for (int j = 0; j < 4; ++j) { unsigned w[4];
#pragma unroll
        for (int t = 0; t < 4; ++t) { float x[4];
#pragma unroll
            for (int e = 0; e < 4; ++e) { const v2u v = c[4 * t + e]; const unsigned wd = j < 2 ? v.x : v.y; x[e] = (j & 1) ? bfhi(wd) : bflo(wd); }
            w[t] = (unsigned)qi8(x[0] * inv[j]) | ((unsigned)qi8(x[1] * inv[j]) << 8) | ((unsigned)qi8(x[2] * inv[j]) << 16) | ((unsigned)qi8(x[3] * inv[j]) << 24); }
        v4u o; o.x = w[0]; o.y = w[1]; o.z = w[2]; o.w = w[3];
        *(GAS v4u*)(dst + (size_t)j * D) = o; }
}
template <int CTRL> __device__ __forceinline__ float dppf(float v) { return __builtin_bit_cast(float, __builtin_amdgcn_mov_dpp(__builtin_bit_cast(int, v), CTRL, 0xF, 0xF, true)); }
__device__ __forceinline__ float lx1(float v) { return dppf<0xB1>(v); }
__device__ __forceinline__ float lx2(float v) { return dppf<0x4E>(v); }
__device__ __forceinline__ float lx4(float v) { return dppf<0x141>(dppf<0x1B>(v)); }
__device__ __forceinline__ void had32_item(f32x4 (&a)[16], int lane) {
#pragma unroll
    for (int h = 1; h < 16; h <<= 1)
#pragma unroll
        for (int i = 0; i < 16; ++i) if (!(i & h)) { const f32x4 x = a[i], y = a[i + h]; a[i] = x + y; a[i + h] = x - y; }
    const bool up = (lane & 1) != 0;
#pragma unroll
    for (int i = 0; i < 16; ++i) { f32x4 p; p.x = lx1(a[i].x); p.y = lx1(a[i].y); p.z = lx1(a[i].z); p.w = lx1(a[i].w);
        a[i] = (up ? p - a[i] : a[i] + p) * 0.17677669529663687f; }
}
__device__ __forceinline__ void gu_slab(Frame& F, int slab) {
    const int tid = F.tid, lane = F.lane, wave = F.wave;
    const int which = slab >= 1504 ? 3 : (slab >= 1376 ? 2 : (slab >= 688 ? 1 : 0)), nb = which == 3 ? slab - 1504 : slab - 688 * which, pn = nb >> 3, q = nb & 7;
    const int src_col = which == 3 ? (nb < 32 ? 32 * nb : 4096 + 32 * (nb - 32)) : (which == 2 ? 32 * nb : (q < 4 ? 128 * pn + 32 * q : DFF + 128 * pn + 32 * (q - 4))), dst_row = 32 * nb;
    const int ldw = which == 3 ? D_IN_SRC : (which == 2 ? D : NGU);
    const float* W = inp(F, which == 3 ? IN_WIN : (which == 2 ? IN_WOUT : (which ? IN_WGU2 : IN_WGU1)));
    unsigned char* WT = F.ws + (which == 3 ? WS_WOUT + 16 * MiB : (which == 2 ? WS_WOUT : (which ? WS_WGU2 : WS_WGU1))); float* SWp = (float*)(F.ws + WS_SW) + (which == 3 ? 2 * NGU + D : which * NGU);
    LAS unsigned char* CW = F.lds + wave * GUC_WAVE;
    LAS float* cm = (LAS float*)(F.lds + GUC_END); LAS float* isc = cm + 256;
    const int kc = lane & 7, nq = lane >> 3;
    const float* src = W + (size_t)(512 * wave + 16 * kc) * ldw + src_col + 4 * nq; unsigned char* dst = WT + (size_t)(dst_row + 4 * nq) * D + 512 * wave + 16 * kc;
    v2u P[2][16]; f32x4 m4 = {0.f, 0.f, 0.f, 0.f};
#pragma unroll
    for (int it = 0; it < 2; ++it) { f32x4 a[16];
        gu_slab_load(src + (size_t)(128 * it) * ldw, ldw, a);
        if (which == 2) had32_item(a, lane);
#pragma unroll
        for (int j = 0; j < 16; ++j) { const f32x4 v = a[j]; m4.x = fmaxf(m4.x, fabsf(v.x)); m4.y = fmaxf(m4.y, fabsf(v.y)); m4.z = fmaxf(m4.z, fabsf(v.z)); m4.w = fmaxf(m4.w, fabsf(v.w));
            P[it][j].x = pk2(v.x, v.y); P[it][j].y = pk2(v.z, v.w); } }
#pragma unroll 1
    for (int it = 2; it < 4; ++it) { f32x4 a[16];
        gu_slab_load(src + (size_t)(128 * it) * ldw, ldw, a);
        if (which == 2) had32_item(a, lane);
#pragma unroll
        for (int j = 0; j < 16; ++j) { const f32x4 v = a[j]; m4.x = fmaxf(m4.x, fabsf(v.x)); m4.y = fmaxf(m4.y, fabsf(v.y)); m4.z = fmaxf(m4.z, fabsf(v.z)); m4.w = fmaxf(m4.w, fabsf(v.w));
            v2u o; o.x = pk2(v.x, v.y); o.y = pk2(v.z, v.w); *(LAS v2u*)(CW + (8 * (it - 2) + kc) * 1056 + j * 64 + nq * 8) = o; } }
#pragma unroll
    for (int j = 0; j < 4; ++j) { m4[j] = fmaxf(m4[j], __shfl_xor(m4[j], 1)); m4[j] = fmaxf(m4[j], __shfl_xor(m4[j], 2)); m4[j] = fmaxf(m4[j], __shfl_xor(m4[j], 4)); }
    if (kc == 0) *(LAS f32x4*)(cm + wave * 32 + 4 * nq) = m4;
    __syncthreads();
    if (tid < 32) { float mx = 0.f;
#pragma unroll
        for (int w = 0; w < 8; ++w) mx = fmaxf(mx, cm[w * 32 + tid]);
        const float sc = mx > 0.f ? mx * (1.0f / 127.0f) : 1.0f; SWp[dst_row + tid] = sc; isc[tid] = 1.0f / sc; }
    __syncthreads();
    { const f32x4 inv = *(const LAS f32x4*)(isc + 4 * nq);
      v2u C[16];
#pragma unroll
      for (int it = 0; it < 2; ++it) {
#pragma unroll
          for (int i = 0; i < 16; ++i) C[i] = *(const LAS v2u*)(CW + (8 * it + kc) * 1056 + i * 64 + nq * 8);
          gu_slab_store_bf(dst + 256 + 128 * it, C, inv); }
      gu_slab_store_bf(dst, P[0], inv);
      gu_slab_store_bf(dst + 128, P[1], inv); }
    __syncthreads();
}
#ifndef P0DUP
#define P0DUP 0
#endif
__device__ __forceinline__ void p0_prologue(Frame& F) {
    const int tid = F.tid, lane = F.lane, wave = F.wave;
    LAS float* S = (LAS float*)(F.lds);
    for (int i = tid; i < 3 * D; i += 512) { const int mi = i >> 12, k = i & 4095; const float c = mi == 0 ? inp(F, IN_CCTX)[k] : inp(F, IN_C)[(mi - 1) * D + k]; S[i] = c / (1.0f + expf(-c)); }
    __syncthreads();
    _Pragma("unroll 1") for (int r_ = 0; r_ < ((P0DUP & 1) ? 2 : 1); ++r_)
    for (int g = blockIdx.x; g < 128; g += F.G) s5_prep(F, g);
    {
        LAS float* red = (LAS float*)(F.lds + 49152);
        float* MODP = (float*)(F.ws + WS_MODP);
        _Pragma("unroll 1") for (int r_ = 0; r_ < ((P0DUP & 2) ? 2 : 1); ++r_)
        for (int it = blockIdx.x; it < 576; it += F.G) {
            const int ct = it % 144, kq = it / 144;
            f32x4 a0 = {0.f, 0.f, 0.f, 0.f}, a1 = a0, a2 = a0;
            const float* wp = inp(F, IN_WADA) + (size_t)(1024 * kq + 128 * wave) * NMODC + 256 * ct + 4 * lane;
            const LAS float* sp = S + 1024 * kq + 128 * wave;
#pragma unroll 16
            for (int i = 0; i < 128; ++i) { const f32x4 v = *(const GAS f32x4*)(wp + (size_t)i * NMODC); const float s0 = sp[i], s1 = sp[D + i], s2 = sp[2 * D + i];
                a0 += s0 * v; a1 += s1 * v; a2 += s2 * v; }
            *(LAS f32x4*)(red + (wave * 3 + 0) * 256 + 4 * lane) = a0; *(LAS f32x4*)(red + (wave * 3 + 1) * 256 + 4 * lane) = a1; *(LAS f32x4*)(red + (wave * 3 + 2) * 256 + 4 * lane) = a2;
            __syncthreads();
            for (int o = tid; o < 768; o += 512) { const int mi = o >> 8, c = o & 255; float sum = 0.f;
#pragma unroll
                for (int w = 0; w < 8; ++w) sum += red[(w * 3 + mi) * 256 + c];
                MODP[(size_t)(kq * 3 + mi) * NMODC + 256 * ct + c] = sum; }
            __syncthreads();
        }
    }
    _Pragma("unroll 1") for (int r_ = 0; r_ < ((P0DUP & 4) ? 2 : 1); ++r_)
    for (int sl = blockIdx.x; sl < 1600; sl += F.G) gu_slab(F, sl);
    for (int e = blockIdx.x * 512 + tid; e < 2048; e += F.G * 512) { const int pos = e >> 5, i = e & 31; const float fq = powf(10000.0f, -(float)i / 32.0f), ang = (float)pos * fq;
        float* r = (float*)(F.ws + WS_ROPE) + e * 2; r[0] = cosf(ang); r[1] = sinf(ang); }
    {
        unsigned* ctr = (unsigned*)(F.ctl + CW_QUEUE);
        unsigned nb_v = 0u;
        if (lane == 0) nb_v = __hip_atomic_fetch_add(ctr, 8u, RLX_AGENT);
        int base = __builtin_amdgcn_readfirstlane((int)nb_v), pos = 0;
        if (lane == 0) nb_v = __hip_atomic_fetch_add(ctr, 8u, RLX_AGENT);
        f32x4 A[16], B[16];
        int itA = base, itB;
        TrDesc dA = tr_decode(F, itA, lane), dB; tr_load(dA, A);
        for (;;) {
            if (itA >= TR_NITEMS) break;
            if (++pos == 8) { base = __builtin_amdgcn_readfirstlane((int)nb_v); pos = 0; if (lane == 0) nb_v = __hip_atomic_fetch_add(ctr, 8u, RLX_AGENT); }
            itB = base + pos; dB = tr_decode(F, itB, lane); tr_load(dB, B);
            tr_store(dA, A);
            if (itB >= TR_NITEMS) break;
            if (++pos == 8) { base = __builtin_amdgcn_readfirstlane((int)nb_v); pos = 0; if (lane == 0) nb_v = __hip_atomic_fetch_add(ctr, 8u, RLX_AGENT); }
            itA = base + pos; dA = tr_decode(F, itA, lane); tr_load(dA, A);
            tr_store(dB, B);
        }
    }
}

__device__ __forceinline__ f32x4 modv(const float* MODP, const float* bada, int mi, int chunk, int c4) {
    f32x4 r = *((const GAS f32x4*)(bada + chunk * D) + c4);
#pragma unroll
    for (int kq = 0; kq < 4; ++kq) r += *((const GAS f32x4*)(MODP + (size_t)(kq * 3 + mi) * NMODC + chunk * D) + c4);
    return r; }
__device__ __forceinline__ f32x4 bf4(v2u w) { return (f32x4){bflo(w.x), bfhi(w.x), bflo(w.y), bfhi(w.y)}; }
template <int MODE> __device__ __forceinline__ void norm_phase(Frame& F) {
    const int gw = F.vcu * NWAVES + F.wave, NGW = F.G * NWAVES, lane = F.lane, tid = F.tid;
    const float* NW = inp(F, IN_NORMW); const float* MODP = (const float*)(F.ws + WS_MODP); const float* BADA = inp(F, IN_BADA);
    bf16* X1 = (bf16*)(F.ws + WS_X1); const bf16* FFO = (const bf16*)(F.ws + WS_FFO); bf16* H = (bf16*)(F.ws + WS_H);
    LAS f32x4* LG = (LAS f32x4*)F.lds; LAS f32x4* LA = LG + 1024; LAS f32x4* LS = LG + 2048;
    constexpr int gch = MODE == 1 ? 2 : (MODE == 2 ? 5 : 8), nwa = MODE == 1 ? 1 : (MODE == 2 ? 3 : 5); constexpr float gs = MODE == 2 ? 1.0f : 0.5f;
    constexpr int sh = MODE == 0 ? 0 : (MODE == 1 ? 3 : 6), sc = sh + 1, nwb = MODE == 0 ? 0 : (MODE == 1 ? 2 : 4);
    int staged = -1;
    for (int m = gw; m < M; m += NGW) {
        const int mi = mod_idx(m);
        if (mi != staged) {
            __syncthreads();
#pragma unroll
            for (int e = 0; e < 2; ++e) { const int c4 = tid * 2 + e;
                if (MODE != 0) { const f32x4 g = modv(MODP, BADA, mi, gch, c4), w = *((const GAS f32x4*)(NW + nwa * D) + c4); LG[c4] = (g * w) * gs; }
                if (MODE != 3) { const f32x4 w = *((const GAS f32x4*)(NW + nwb * D) + c4), c = modv(MODP, BADA, mi, sc, c4), s2 = modv(MODP, BADA, mi, sh, c4); LA[c4] = w * (1.0f + c); LS[c4] = s2; } }
            __syncthreads();
            staged = mi;
        }
        f32x4 v[16];
        if (MODE == 0) {
            const GAS f32x4* xr = (const GAS f32x4*)xrow(F, m) + lane;
#pragma unroll
            for (int j = 0; j < 16; ++j) v[j] = xr[64 * j];
        } else {
            const GAS v2u* fr = (const GAS v2u*)(FFO + (size_t)m * D) + lane; float ss = 0.f;
            const GAS f32x4* xr = (const GAS f32x4*)(MODE == 1 ? xrow(F, m) : nullptr) + lane; const GAS v2u* xb = (const GAS v2u*)(X1 + (size_t)m * D) + lane;
            v2u fw[16]; f32x4 xf[MODE == 1 ? 16 : 1]; v2u xw[MODE == 1 ? 1 : 16];
#pragma unroll
            for (int j = 0; j < 16; ++j) fw[j] = fr[64 * j];
#pragma unroll
            for (int j = 0; j < 16; ++j) { if (MODE == 1) xf[j] = xr[64 * j]; else xw[j] = xb[64 * j]; }
#pragma unroll
            for (int j = 0; j < 16; ++j) { v[j] = bf4(fw[j]); ss += (v[j].x * v[j].x + v[j].y * v[j].y) + (v[j].z * v[j].z + v[j].w * v[j].w); }
            const float r = 1.0f / sqrtf(wave_sum(ss) * (1.f / D) + EPS);
            GAS f32x4* orow = (GAS f32x4*)(F.out + OUT_Y + (size_t)m * D) + lane; GAS v2u* ob = (GAS v2u*)(X1 + (size_t)m * D) + lane;
#pragma unroll
            for (int j = 0; j < 16; ++j) { const f32x4 x = MODE == 1 ? xf[MODE == 1 ? j : 0] : bf4(xw[MODE == 1 ? 0 : j]); v[j] = x + (v[j] * r) * LG[lane + 64 * j];
                if (MODE == 3) orow[64 * j] = v[j]; else { v2u o; o.x = pk2(v[j].x, v[j].y); o.y = pk2(v[j].z, v[j].w); ob[64 * j] = o; } }
        }
        if (MODE != 3) {
            float ss = 0.f;
#pragma unroll
            for (int j = 0; j < 16; ++j) ss += (v[j].x * v[j].x + v[j].y * v[j].y) + (v[j].z * v[j].z + v[j].w * v[j].w);
            const float r = 1.0f / sqrtf(wave_sum(ss) * (1.f / D) + EPS);
            GAS v2u* o8 = (GAS v2u*)(H + (size_t)m * D) + lane; GAS unsigned* o4 = (GAS unsigned*)((unsigned char*)H + (size_t)m * D) + lane;
            if (MK_FP8 && MODE != 1) {
                float mx = 0.f;
#pragma unroll
                for (int j = 0; j < 16; ++j) { v[j] = (v[j] * r) * LA[lane + 64 * j] + LS[lane + 64 * j];
                    mx = fmaxf(fmaxf(mx, fmaxf(fabsf(v[j].x), fabsf(v[j].y))), fmaxf(fabsf(v[j].z), fabsf(v[j].w))); }
#pragma unroll
                for (int o = 1; o < 64; o <<= 1) mx = fmaxf(mx, __shfl_xor(mx, o));
                const float scl = mx > 0.f ? mx * (1.0f / 127.0f) : 1.0f, inv = 1.0f / scl;
                if (lane == 0) ((float*)(F.ws + WS_SA))[m] = scl;
#pragma unroll
                for (int j = 0; j < 16; ++j) o4[64 * j] = (unsigned)qi8(v[j].x * inv) | ((unsigned)qi8(v[j].y * inv) << 8) | ((unsigned)qi8(v[j].z * inv) << 16) | ((unsigned)qi8(v[j].w * inv) << 24);
            } else {
                float mx = 0.f;
#pragma unroll
                for (int j = 0; j < 16; ++j) { const f32x4 h = (v[j] * r) * LA[lane + 64 * j] + LS[lane + 64 * j]; v[j] = h;
                    mx = fmaxf(fmaxf(mx, fmaxf(fabsf(h.x), fabsf(h.y))), fmaxf(fabsf(h.z), fabsf(h.w)));
                    v2u o; o.x = pk2(h.x, h.y); o.y = pk2(h.z, h.w); o8[64 * j] = o; }
                if (MK_FP8 && MODE == 1) {
#pragma unroll
                    for (int o = 1; o < 64; o <<= 1) mx = fmaxf(mx, __shfl_xor(mx, o));
                    const float scl = mx > 0.f ? mx * (1.0f / 127.0f) : 1.0f, inv = 1.0f / scl;
                    if (lane == 0) ((float*)(F.ws + WS_SA))[m] = scl;
                    GAS unsigned* q4 = (GAS unsigned*)(F.ws + WS_ACT + (size_t)m * D) + lane;
#pragma unroll
                    for (int j = 0; j < 16; ++j) q4[64 * j] = (unsigned)qi8(v[j].x * inv) | ((unsigned)qi8(v[j].y * inv) << 8) | ((unsigned)qi8(v[j].z * inv) << 16) | ((unsigned)qi8(v[j].w * inv) << 24);
                }
            }
        }
    }
    __syncthreads();
}
__device__ __forceinline__ f32x4 had32_act(const f32x4 v, float s1, float s2, float s4) {
    const f32x4 a = {v.x + v.y, v.x - v.y, v.z + v.w, v.z - v.w};
    f32x4 b = {a.x + a.z, a.y + a.w, a.x - a.z, a.y - a.w};
    { f32x4 p; p.x = lx1(b.x); p.y = lx1(b.y); p.z = lx1(b.z); p.w = lx1(b.w); b = b * s1 + p; }
    { f32x4 p; p.x = lx2(b.x); p.y = lx2(b.y); p.z = lx2(b.z); p.w = lx2(b.w); b = b * s2 + p; }
    { f32x4 p; p.x = lx4(b.x); p.y = lx4(b.y); p.z = lx4(b.z); p.w = lx4(b.w); b = b * s4 + p; }
    return b * 0.17677669529663687f;
}
__device__ __forceinline__ unsigned q4i8(const f32x4 v, float inv) { return (unsigned)qi8(v.x * inv) | ((unsigned)qi8(v.y * inv) << 8) | ((unsigned)qi8(v.z * inv) << 16) | ((unsigned)qi8(v.w * inv) << 24); }
__device__ __forceinline__ void gla_post_phase(Frame& F) {
    const int gw = F.vcu * NWAVES + F.wave, NGW = F.G * NWAVES, lane = F.lane;
    const bf16* OFp = (const bf16*)(F.ws + WS_OF); const bf16* OBp = (const bf16*)(F.ws + WS_OB); const bf16* PROJ = (const bf16*)(F.ws + WS_PROJ); const bf16* CAT = (const bf16*)(F.ws + WS_CAT);
    unsigned char* CATQ = F.ws + WS_H; float* SA2 = (float*)(F.ws + WS_SA);
    const float hs1 = (lane & 1) ? -1.f : 1.f, hs2 = (lane & 2) ? -1.f : 1.f, hs4 = (lane & 4) ? -1.f : 1.f;
    const f32x4 gn = *((const GAS f32x4*)inp(F, IN_GNW) + lane);
    for (int m = gw; m < M; m += NGW) {
        const GAS v2u* a = (const GAS v2u*)(OFp + (size_t)m * SW) + lane; const GAS v2u* b = (const GAS v2u*)(OBp + (size_t)m * SW) + lane;
        const GAS v2u* gp = (const GAS v2u*)(PROJ + (size_t)m * NIN + PJ_G) + lane; const GAS v2u* sp = (const GAS v2u*)(CAT + (size_t)m * D + SW) + lane;
        GAS unsigned* op = (GAS unsigned*)(CATQ + (size_t)m * D) + lane;
        v2u ra[8], rb[8], rg[8], rs[8]; f32x4 ov[8], ys[8]; float ssq[8];
#pragma unroll
        for (int j = 0; j < 8; ++j) { ra[j] = a[64 * j]; rb[j] = b[64 * j]; rg[j] = gp[64 * j]; rs[j] = sp[64 * j]; }
#pragma unroll
        for (int j = 0; j < 8; ++j) { ov[j] = bf4(ra[j]) + bf4(rb[j]); ssq[j] = (ov[j].x * ov[j].x + ov[j].y * ov[j].y) + (ov[j].z * ov[j].z + ov[j].w * ov[j].w); }
#pragma unroll
        for (int o = 1; o < 64; o <<= 1) {
#pragma unroll
            for (int j = 0; j < 8; ++j) ssq[j] += __shfl_xor(ssq[j], o); }
        float amax = 0.f;
#pragma unroll
        for (int j = 0; j < 8; ++j) { const f32x4 o = ov[j]; const v2u gw2 = rg[j]; const float r = 1.0f / sqrtf(ssq[j] * (1.f / 256.f) + EPS);
            const float g0 = bflo(gw2.x), g1 = bfhi(gw2.x), g2 = bflo(gw2.y), g3 = bfhi(gw2.y);
            f32x4 x; x.x = o.x * r * gn.x * (g0 / (1.0f + __expf(-g0))); x.y = o.y * r * gn.y * (g1 / (1.0f + __expf(-g1))); x.z = o.z * r * gn.z * (g2 / (1.0f + __expf(-g2))); x.w = o.w * r * gn.w * (g3 / (1.0f + __expf(-g3)));
            x = had32_act(x, hs1, hs2, hs4); const f32x4 y = had32_act(bf4(rs[j]), hs1, hs2, hs4); ov[j] = x; ys[j] = y;
            amax = fmaxf(amax, fmaxf(fmaxf(fabsf(x.x), fabsf(x.y)), fmaxf(fabsf(x.z), fabsf(x.w)))); amax = fmaxf(amax, fmaxf(fmaxf(fabsf(y.x), fabsf(y.y)), fmaxf(fabsf(y.z), fabsf(y.w)))); }
#pragma unroll
        for (int o = 1; o < 64; o <<= 1) amax = fmaxf(amax, __shfl_xor(amax, o));
        const float sc = amax > 0.f ? amax * (1.0f / 127.0f) : 1.0f, inv = 1.0f / sc;
#pragma unroll
        for (int j = 0; j < 8; ++j) { op[64 * j] = q4i8(ov[j], inv); op[512 + 64 * j] = q4i8(ys[j], inv); }
        if (lane == 0) SA2[m] = sc;
    }
}

__device__ __forceinline__ void lr_mini_gemm(Frame& F) {
    const bf16* H = (const bf16*)(F.ws + WS_H); const bf16* WL = (const bf16*)(F.ws + WS_WLR); float* LR = (float*)(F.ws + WS_LR);
    LAS float* red = (LAS float*)F.lds;
    const int lane = F.lane, wave = F.wave, n16 = lane & 15, kq = lane >> 4;
    const int half = F.G / 2;
    for (int rb = (int)blockIdx.x - half; rb >= 0 && rb < M / 32; rb += (F.G - half)) {
        const int r0 = 32 * rb;
        f32x4 acc[2][2];
#pragma unroll
        for (int a = 0; a < 2; ++a)
#pragma unroll
            for (int b = 0; b < 2; ++b) acc[a][b] = (f32x4){0.f, 0.f, 0.f, 0.f};
#pragma unroll 4
        for (int ks = 0; ks < 16; ++ks) { const int k = 512 * wave + 32 * ks + 8 * kq;
            bf16x8 av[2], bv[2];
#pragma unroll
            for (int a = 0; a < 2; ++a) { av[a] = *(const GAS bf16x8*)(H + (size_t)(r0 + 16 * a + n16) * D + k); bv[a] = *(const GAS bf16x8*)(WL + (size_t)(16 * a + n16) * D + k); }
#pragma unroll
            for (int a = 0; a < 2; ++a)
#pragma unroll
                for (int b = 0; b < 2; ++b) acc[a][b] = __builtin_amdgcn_mfma_f32_16x16x32_bf16(av[a], bv[b], acc[a][b], 0, 0, 0);
        }
        __syncthreads();
#pragma unroll
        for (int a = 0; a < 2; ++a)
#pragma unroll
            for (int b = 0; b < 2; ++b)
#pragma unroll
                for (int i = 0; i < 4; ++i) red[(wave * 32 + 16 * a + 4 * kq + i) * 32 + 16 * b + n16] = acc[a][b][i];
        __syncthreads();
#pragma unroll
        for (int j = 0; j < 2; ++j) { const int o = F.tid + 512 * j; float s = 0.f;
#pragma unroll
            for (int w = 0; w < 8; ++w) s += red[w * 1024 + o];
            LR[(size_t)r0 * 32 + o] = s; }
    }
    __syncthreads();
}

constexpr int GI_P = 0, GI_QE = 9216, GI_KDT = 26624, GI_EB = 45056, GI_BYTES = 45568, GV_SLICE = 9216, GV_BYTES = 36864;
constexpr int GP_QS = 0, GP_KS = 17408, GP_IMG = 34816, GP_VT = GP_IMG + GI_BYTES, GP_LRS = GP_VT + GV_BYTES, GP_TOTS = GP_LRS + 4096;
__device__ __forceinline__ float log_sigmoid_f(float x) { return fminf(x, 0.f) - __logf(1.0f + __expf(-fabsf(x))); }
__device__ __forceinline__ void gla_prep_unit(Frame& F, int u) {
    LAS unsigned char* L = F.lds;
    const int tid = F.tid, lane = F.lane, w = F.wave, hh = lane >> 5, l31 = lane & 31;
    const int col = tid & 127, tg = tid >> 7;
    int b, h, d, ci, rowbase, rope;
    if (u < 1024) { b = u >> 9; h = (u >> 6) & 7; d = (u >> 5) & 1; ci = u & 31; rowbase = MP + b * 2048; rope = 1; }
    else { const int v = u - 1024; b = v >> 6; h = (v >> 3) & 7; d = (v >> 2) & 1; ci = v & 3; rowbase = b * 256; rope = 0; }
    const int m0 = rowbase + 64 * ci;
    const bf16* PROJ = (const bf16*)(F.ws + WS_PROJ); const float* LRp = (const float*)(F.ws + WS_LR); const float* ROPE = (const float*)(F.ws + WS_ROPE);
    unsigned short qv[16], kv[16];
#pragma unroll
    for (int tt = 0; tt < 16; ++tt) { const size_t m = (size_t)(m0 + 16 * tg + tt); qv[tt] = PROJ[m * NIN + PJ_Q + h * 128 + col]; kv[tt] = PROJ[m * NIN + PJ_K + h * 128 + col]; }
    float Wg[16];
#pragma unroll
    for (int r = 0; r < 16; ++r) Wg[r] = inp(F, IN_WGATE)[(d * 16 + r) * 1024 + h * 128 + col];
    const float bg = inp(F, IN_BGATE)[d * 1024 + h * 128 + col];
    __syncthreads();
    if (tid < 256) { const int tok = tid >> 2, r4 = tid & 3; *(LAS f32x4*)(L + GP_LRS + tok * 64 + r4 * 16) = *(const GAS f32x4*)(LRp + (size_t)(m0 + tok) * 32 + d * 16 + r4 * 4); }
    if (d == 0) {
        const int dv = tid & 255, half = tid >> 8; unsigned short vv[32];
#pragma unroll
        for (int j = 0; j < 32; ++j) vv[j] = PROJ[(size_t)(m0 + 32 * half + j) * NIN + PJ_V + h * 256 + dv];
#pragma unroll
        for (int j4 = 0; j4 < 4; ++j4) { v4u o; o.x = vv[8 * j4] | ((unsigned)vv[8 * j4 + 1] << 16); o.y = vv[8 * j4 + 2] | ((unsigned)vv[8 * j4 + 3] << 16); o.z = vv[8 * j4 + 4] | ((unsigned)vv[8 * j4 + 5] << 16); o.w = vv[8 * j4 + 6] | ((unsigned)vv[8 * j4 + 7] << 16);
            *(LAS v4u*)(L + GP_VT + (dv >> 6) * GV_SLICE + (dv & 63) * 144 + half * 64 + j4 * 16) = o; }
    }
    __syncthreads();
    float c[16];
#pragma unroll
    for (int tt = 0; tt < 16; ++tt) { const LAS f32x4* lp = (const LAS f32x4*)(L + GP_LRS + (16 * tg + tt) * 64); float lg = bg;
#pragma unroll
        for (int r4 = 0; r4 < 4; ++r4) { const f32x4 x = lp[r4]; lg += x.x * Wg[4 * r4] + x.y * Wg[4 * r4 + 1] + x.z * Wg[4 * r4 + 2] + x.w * Wg[4 * r4 + 3]; }
        c[tt] = log_sigmoid_f(lg) * (1.0f / 16.0f); }
    if (d == 0) {
#pragma unroll
        for (int tt = 1; tt < 16; ++tt) c[tt] += c[tt - 1];
    } else {
#pragma unroll
        for (int tt = 14; tt >= 0; --tt) c[tt] += c[tt + 1];
    }
    ((LAS float*)(L + GP_TOTS))[tg * 128 + col] = d ? c[0] : c[15];
    __syncthreads();
    const float t0 = ((LAS float*)(L + GP_TOTS))[col], t1 = ((LAS float*)(L + GP_TOTS))[128 + col], t2 = ((LAS float*)(L + GP_TOTS))[256 + col], t3 = ((LAS float*)(L + GP_TOTS))[384 + col];
    float off, ref; const float blast = (t0 + t1) + (t2 + t3);
    if (d == 0) { off = tg == 0 ? 0.f : (tg == 1 ? t0 : (tg == 2 ? t0 + t1 : t0 + t1 + t2)); ref = t0 + t1; }
    else { off = tg == 3 ? 0.f : (tg == 2 ? t3 : (tg == 1 ? t3 + t2 : t3 + t2 + t1)); ref = t2 + t3; }
    if (tg == 0) ((LAS float*)(L + GP_IMG + GI_EB))[col] = __expf(blast);
    const float e_ref = __expf(ref), e_lr = __expf(blast - ref);
    unsigned short kd[16];
#pragma unroll
    for (int tt = 0; tt < 16; ++tt) { const int tok = 16 * tg + tt;
        float q = bf2f(qv[tt]), k = bf2f(kv[tt]);
        if (rope) { const float qp = __shfl_xor(q, 32), kp = __shfl_xor(k, 32); const int pos = col < 64 ? ci : tok; const f32x2 cs = *(const GAS f32x2*)(ROPE + (pos * 32 + (col & 31)) * 2);
            if ((col & 32) == 0) { q = q * cs.x - qp * cs.y; k = k * cs.x - kp * cs.y; } else { q = qp * cs.y + q * cs.x; k = kp * cs.y + k * cs.x; } }
        q *= 0.08838834764831845f;
        const float bc = c[tt] + off;
        const float e1 = __expf(bc - ref), e2 = __builtin_amdgcn_rcpf(e1); const float qs = q * e1, ks = k * e2;
        ((LAS unsigned short*)(L + GP_QS + tok * 272))[col] = (unsigned short)f2bf(qs);
        ((LAS unsigned short*)(L + GP_KS + tok * 272))[col] = (unsigned short)f2bf(ks);
        ((LAS unsigned short*)(L + GP_IMG + GI_QE + tok * 272))[col] = (unsigned short)f2bf(qs * e_ref);
        kd[tt] = (unsigned short)f2bf(ks * e_lr); }
    { v4u o0, o1; o0.x = kd[0] | ((unsigned)kd[1] << 16); o0.y = kd[2] | ((unsigned)kd[3] << 16); o0.z = kd[4] | ((unsigned)kd[5] << 16); o0.w = kd[6] | ((unsigned)kd[7] << 16);
      o1.x = kd[8] | ((unsigned)kd[9] << 16); o1.y = kd[10] | ((unsigned)kd[11] << 16); o1.z = kd[12] | ((unsigned)kd[13] << 16); o1.w = kd[14] | ((unsigned)kd[15] << 16);
      *(LAS v4u*)(L + GP_IMG + GI_KDT + col * 144 + tg * 32) = o0; *(LAS v4u*)(L + GP_IMG + GI_KDT + col * 144 + tg * 32 + 16) = o1; }
    __syncthreads();
    if (w < 4) {
        const int ib = w >> 1, jb = w & 1; const bool zero = d == 0 ? (ib == 0 && jb == 1) : (ib == 1 && jb == 0);
        f32x16 X;
#pragma unroll
        for (int r = 0; r < 16; ++r) X[r] = 0.f;
        if (!zero) {
#pragma unroll
            for (int ks = 0; ks < 8; ++ks) { const bf16x8 a = *(const LAS bf16x8*)(L + GP_KS + (jb * 32 + l31) * 272 + ks * 32 + hh * 16), bq = *(const LAS bf16x8*)(L + GP_QS + (ib * 32 + l31) * 272 + ks * 32 + hh * 16);
                X = __builtin_amdgcn_mfma_f32_32x32x16_bf16(a, bq, X, 0, 0, 0); }
        }
        const int ig = ib * 32 + l31;
#pragma unroll
        for (int gq = 0; gq < 4; ++gq) { const int j0 = jb * 32 + 8 * gq + 4 * hh; float x[4];
#pragma unroll
            for (int e = 0; e < 4; ++e) { const int j = j0 + e; const bool keep = d == 0 ? (ig >= j) : (ig <= j); x[e] = keep ? X[4 * gq + e] : 0.f; }
            v2u o; o.x = pk2(x[0], x[1]); o.y = pk2(x[2], x[3]); *(LAS v2u*)(L + GP_IMG + GI_P + ig * 144 + j0 * 2) = o; }
    }
    __syncthreads();
    { unsigned char* gi = F.ws + WS_GLAW + (size_t)u * GI_BYTES;
      for (int i = tid; i < GI_BYTES / 16; i += 512) *(GAS v4u*)(gi + i * 16) = *(const LAS v4u*)(L + GP_IMG + i * 16);
      if (d == 0) { unsigned char* gv = F.ws + WS_VTW + (size_t)((m0 >> 6) * 8 + h) * GV_BYTES;
          for (int i = tid; i < GV_BYTES / 16; i += 512) *(GAS v4u*)(gv + i * 16) = *(const LAS v4u*)(L + GP_VT + i * 16); } }
}

constexpr int GS_BUF = GI_BYTES + GV_SLICE, GS_ST = 2 * GS_BUF, GS_NLD = 8;
__device__ __forceinline__ void gla_write_st(LAS unsigned char* L, const f32x16& S, int kb, int vb, int l31, int hh) {
#pragma unroll
    for (int gq = 0; gq < 4; ++gq) { v2u w; w.x = pk2(S[4 * gq + 0], S[4 * gq + 1]); w.y = pk2(S[4 * gq + 2], S[4 * gq + 3]);
        *(LAS v2u*)(L + GS_ST + (vb * 32 + l31) * 272 + (kb * 32 + 8 * gq + 4 * hh) * 2) = w; }
}
__device__ __forceinline__ void gla_scan_load(__amdgpu_buffer_rsrc_t rI, __amdgpu_buffer_rsrc_t rV, int soI, int soV, int tid, v4u (&R)[GS_NLD]) {
#pragma unroll
    for (int j = 0; j < 6; ++j) R[j] = __builtin_amdgcn_raw_buffer_load_b128(rI, tid * 16, soI + j * 8192, 0);
    R[6] = __builtin_amdgcn_raw_buffer_load_b128(rV, tid * 16, soV, 0);
    R[7] = __builtin_amdgcn_raw_buffer_load_b128(rV, tid * 16, soV + 8192, 0);
}
__device__ __forceinline__ void gla_scan_put(LAS unsigned char* buf, int tid, const v4u (&R)[GS_NLD]) {
#pragma unroll
    for (int j = 0; j < 5; ++j) *(LAS v4u*)(buf + (tid + 512 * j) * 16) = R[j];
    if (tid < 288) *(LAS v4u*)(buf + (tid + 2560) * 16) = R[5];
    *(LAS v4u*)(buf + GI_BYTES + tid * 16) = R[6];
    if (tid < 64) *(LAS v4u*)(buf + GI_BYTES + (tid + 512) * 16) = R[7];
}
__device__ __forceinline__ void gla_scan_mma(LAS unsigned char* L, LAS unsigned char* B, f32x16& S, __amdgpu_buffer_rsrc_t rO, int m0, int h, int vs, int w, int l31, int hh) {
    const int kb = w >> 1, vb = w & 1;
    if (w < 4) {
        const int ib = w >> 1, vb2 = w & 1; f32x16 O, O2, O3;
#pragma unroll
        for (int r = 0; r < 16; ++r) { O[r] = 0.f; O2[r] = 0.f; O3[r] = 0.f; }
#pragma unroll
        for (int ks = 0; ks < 4; ++ks) { const bf16x8 a = *(const LAS bf16x8*)(B + GI_BYTES + (vb2 * 32 + l31) * 144 + ks * 32 + hh * 16), bp = *(const LAS bf16x8*)(B + GI_P + (ib * 32 + l31) * 144 + ks * 32 + hh * 16);
            O = __builtin_amdgcn_mfma_f32_32x32x16_bf16(a, bp, O, 0, 0, 0);
            const bf16x8 a2 = *(const LAS bf16x8*)(L + GS_ST + (vb2 * 32 + l31) * 272 + ks * 32 + hh * 16), bq2 = *(const LAS bf16x8*)(B + GI_QE + (ib * 32 + l31) * 272 + ks * 32 + hh * 16);
            O2 = __builtin_amdgcn_mfma_f32_32x32x16_bf16(a2, bq2, O2, 0, 0, 0);
            const bf16x8 a3 = *(const LAS bf16x8*)(L + GS_ST + (vb2 * 32 + l31) * 272 + (ks + 4) * 32 + hh * 16), bq3 = *(const LAS bf16x8*)(B + GI_QE + (ib * 32 + l31) * 272 + (ks + 4) * 32 + hh * 16);
            O3 = __builtin_amdgcn_mfma_f32_32x32x16_bf16(a3, bq3, O3, 0, 0, 0); }
#pragma unroll
        for (int r = 0; r < 16; ++r) O[r] += O2[r] + O3[r];
        const int voff = ((m0 + ib * 32 + l31) * SW + h * 256 + vs * 64 + vb2 * 32 + 4 * hh) * 2;
#pragma unroll
        for (int gq = 0; gq < 4; ++gq) { v2u o; o.x = pk2(O[4 * gq], O[4 * gq + 1]); o.y = pk2(O[4 * gq + 2], O[4 * gq + 3]);
            __builtin_amdgcn_raw_buffer_store_b64(o, rO, voff + gq * 16, 0, 0); }
    }
    const LAS float* eb = (const LAS float*)(B + GI_EB);
#pragma unroll
    for (int reg = 0; reg < 16; ++reg) S[reg] *= eb[kb * 32 + (reg & 3) + 8 * (reg >> 2) + 4 * hh];
#pragma unroll
    for (int ks = 0; ks < 4; ++ks) { const bf16x8 a = *(const LAS bf16x8*)(B + GI_KDT + (kb * 32 + l31) * 144 + ks * 32 + hh * 16), bv = *(const LAS bf16x8*)(B + GI_BYTES + (vb * 32 + l31) * 144 + ks * 32 + hh * 16);
        S = __builtin_amdgcn_mfma_f32_32x32x16_bf16(a, bv, S, 0, 0, 0); }
}
__device__ __forceinline__ void gla_scan_item(Frame& F, int latent, int b, int h, int d, int vs, const float* S0, float* Sout) {
    LAS unsigned char* L = F.lds;
    const int tid = F.tid, lane = F.lane, w = F.wave, hh = lane >> 5, l31 = lane & 31;
    const int nch = latent ? 32 : 4, rowbase = latent ? MP + b * 2048 : b * 256;
    const int ubase = latent ? ((b << 9) | (h << 6) | (d << 5)) : 1024 + ((b << 6) | (h << 3) | (d << 2));
    const __amdgpu_buffer_rsrc_t rI = __builtin_amdgcn_make_buffer_rsrc((void*)(F.ws + WS_GLAW), 0, 2048 * GI_BYTES, 0x00020000);
    const __amdgpu_buffer_rsrc_t rV = __builtin_amdgcn_make_buffer_rsrc((void*)(F.ws + WS_VTW), 0, 1024 * GV_BYTES, 0x00020000);
    const __amdgpu_buffer_rsrc_t rO = __builtin_amdgcn_make_buffer_rsrc((void*)(F.ws + (d ? WS_OB : WS_OF)), 0, M * SW * 2, 0x00020000);
    const int kb = w >> 1, vb = w & 1;
    const int vbase = ((rowbase >> 6) * 8 + h) * GV_BYTES + vs * GV_SLICE;
#define GLA_CI(cc) (d ? nch - 1 - (cc) : (cc))
#define GLA_CL(cc) ((cc) < nch ? (cc) : nch - 1)
#define GLA_LOAD(R, cc) gla_scan_load(rI, rV, (ubase + GLA_CI(GLA_CL(cc))) * GI_BYTES, vbase + GLA_CI(GLA_CL(cc)) * 8 * GV_BYTES, tid, R)
    f32x16 S;
#pragma unroll
    for (int reg = 0; reg < 16; ++reg) { const int dk = kb * 32 + (reg & 3) + 8 * (reg >> 2) + 4 * hh, dv = vs * 64 + vb * 32 + l31; S[reg] = S0 ? S0[dk * 256 + dv] : 0.f; }
    v4u R0[GS_NLD], R1[GS_NLD];
    GLA_LOAD(R0, 0); GLA_LOAD(R1, 1);
    __syncthreads();
    gla_write_st(L, S, kb, vb, l31, hh);
    gla_scan_put(L, tid, R0);
    GLA_LOAD(R0, 2);
    __syncthreads();
    for (int cc = 0; cc < nch; cc += 2) {
        gla_scan_mma(L, L, S, rO, rowbase + 64 * GLA_CI(cc), h, vs, w, l31, hh);
        __syncthreads();
        gla_write_st(L, S, kb, vb, l31, hh);
        gla_scan_put(L + GS_BUF, tid, R1);
        GLA_LOAD(R1, cc + 3);
        __syncthreads();
        gla_scan_mma(L, L + GS_BUF, S, rO, rowbase + 64 * GLA_CI(cc + 1), h, vs, w, l31, hh);
        __syncthreads();
        gla_write_st(L, S, kb, vb, l31, hh);
        if (cc + 2 < nch) gla_scan_put(L, tid, R0);
        GLA_LOAD(R0, cc + 4);
        __syncthreads();
    }
#undef GLA_CI
#undef GLA_CL
#undef GLA_LOAD
    if (Sout) {
#pragma unroll
        for (int reg = 0; reg < 16; ++reg) { const int dk = kb * 32 + (reg & 3) + 8 * (reg >> 2) + 4 * hh, dv = vs * 64 + vb * 32 + l31; Sout[dk * 256 + dv] = S[reg]; }
    }
}

constexpr int S5_ASTR = 528, S5_HSTR = 1040;
constexpr float YQ_S = 8.0f;
__device__ __forceinline__ float gelu_tanh_f(float x) { const float z = 0.7978845608028654f * (x + 0.044715f * x * x * x); return x * __builtin_amdgcn_rcpf(1.0f + __expf(-2.0f * z)); }
__device__ __forceinline__ void s5_unit(Frame& F, int g, int q) {
    LAS unsigned char* L = F.lds;
    const int tid = F.tid, lane = F.lane, w = F.wave, n16 = lane & 15, kq = lane >> 4;
    const bf16* PROJ = (const bf16*)(F.ws + WS_PROJ); bf16* YS5 = (bf16*)(F.ws + WS_YS5); unsigned char* YQ8 = F.ws + WS_ACT;
    const int mbase = q * 2048;
    __syncthreads();
    for (int i = tid; i < 2048; i += 512) { const int r = i >> 4, s = i & 15; const GAS v4u* src = (const GAS v4u*)(PROJ + (size_t)(mbase + 16 * r + s) * NIN + PJ_U + g * 16);
        const v4u v0 = src[0], v1 = src[1]; *(LAS v4u*)(L + r * S5_ASTR + s * 32) = v0; *(LAS v4u*)(L + r * S5_ASTR + s * 32 + 16) = v1; }
    __syncthreads();
    f32x4 Y[8][2], Hh[8][2];
#pragma unroll
    for (int rb = 0; rb < 8; ++rb)
#pragma unroll
        for (int cb = 0; cb < 2; ++cb) { Y[rb][cb] = (f32x4){0.f, 0.f, 0.f, 0.f}; Hh[rb][cb] = (f32x4){0.f, 0.f, 0.f, 0.f}; }
    const bf16* B1 = (const bf16*)(F.ws + WS_S5B1) + (size_t)g * 512 * 256;
#pragma unroll 2
    for (int ks = 0; ks < 8; ++ks) {
        bf16x8 by[2], bh[2];
#pragma unroll
        for (int cb = 0; cb < 2; ++cb) { by[cb] = *(const GAS bf16x8*)(B1 + (size_t)(32 * w + 16 * cb + n16) * 256 + 32 * ks + 8 * kq); bh[cb] = *(const GAS bf16x8*)(B1 + (size_t)(256 + 32 * w + 16 * cb + n16) * 256 + 32 * ks + 8 * kq); }
#pragma unroll
        for (int rb = 0; rb < 8; ++rb) { const bf16x8 a = *(const LAS bf16x8*)(L + (16 * rb + n16) * S5_ASTR + ks * 64 + kq * 16);
#pragma unroll
            for (int cb = 0; cb < 2; ++cb) { Y[rb][cb] = __builtin_amdgcn_mfma_f32_16x16x32_bf16(a, by[cb], Y[rb][cb], 0, 0, 0); Hh[rb][cb] = __builtin_amdgcn_mfma_f32_16x16x32_bf16(a, bh[cb], Hh[rb][cb], 0, 0, 0); } }
    }
    __syncthreads();
#pragma unroll
    for (int rb = 0; rb < 8; ++rb)
#pragma unroll
        for (int cb = 0; cb < 2; ++cb)
#pragma unroll
            for (int i = 0; i < 4; ++i) *(LAS float*)(L + (16 * rb + 4 * kq + i) * S5_HSTR + (32 * w + 16 * cb + n16) * 4) = Hh[rb][cb][i];
    __syncthreads();
    if (tid < 128) {
        const int dir = tid >> 6, p = tid & 63; const f32x2 a16 = *(const GAS f32x2*)((const float*)(F.ws + WS_A16) + ((g * 2 + dir) * 64 + p) * 2);
        const int colr = (dir * 128 + p) * 4, coli = (dir * 128 + 64 + p) * 4;
        if (q < 2) {
            for (int seq = 0; seq < 8; ++seq) { float hr = 0.f, hi = 0.f;
#pragma unroll
                for (int j8 = 0; j8 < 2; ++j8) { float lr[8], li[8];
#pragma unroll
                    for (int jj = 0; jj < 8; ++jj) { const int r = seq * 16 + (dir ? 15 - (j8 * 8 + jj) : j8 * 8 + jj); lr[jj] = *(const LAS float*)(L + r * S5_HSTR + colr); li[jj] = *(const LAS float*)(L + r * S5_HSTR + coli); }
#pragma unroll
                    for (int jj = 0; jj < 8; ++jj) { const int r = seq * 16 + (dir ? 15 - (j8 * 8 + jj) : j8 * 8 + jj); *(LAS float*)(L + r * S5_HSTR + colr) = hr; *(LAS float*)(L + r * S5_HSTR + coli) = hi;
                        const float nr = a16.x * hr - a16.y * hi + lr[jj], ni = a16.x * hi + a16.y * hr + li[jj]; hr = nr; hi = ni; } }
                const int b = q * 8 + seq; F.out[OUT_S5R + ((size_t)(b * 2 + dir) * 128 + g) * 64 + p] = hr; F.out[OUT_S5I + ((size_t)(b * 2 + dir) * 128 + g) * 64 + p] = hi; }
        } else {
            const int b = q - 2; float hr = inp(F, IN_SS5R)[((size_t)(b * 2 + dir) * 128 + g) * 64 + p], hi = inp(F, IN_SS5I)[((size_t)(b * 2 + dir) * 128 + g) * 64 + p];
            for (int j8 = 0; j8 < 16; ++j8) { float lr[8], li[8];
#pragma unroll
                for (int jj = 0; jj < 8; ++jj) { const int r0 = j8 * 8 + jj, r = dir ? 127 - r0 : r0; lr[jj] = *(const LAS float*)(L + r * S5_HSTR + colr); li[jj] = *(const LAS float*)(L + r * S5_HSTR + coli); }
#pragma unroll
                for (int jj = 0; jj < 8; ++jj) { const int r0 = j8 * 8 + jj, r = dir ? 127 - r0 : r0; *(LAS float*)(L + r * S5_HSTR + colr) = hr; *(LAS float*)(L + r * S5_HSTR + coli) = hi;
                    const float nr = a16.x * hr - a16.y * hi + lr[jj], ni = a16.x * hi + a16.y * hr + li[jj]; hr = nr; hi = ni; }
            }
        }
    }
    __syncthreads();
    const bf16* B2 = (const bf16*)(F.ws + WS_S5B2) + (size_t)g * 256 * 256;
#pragma unroll 2
    for (int ks = 0; ks < 8; ++ks) {
        bf16x8 b2[2];
#pragma unroll
        for (int cb = 0; cb < 2; ++cb) b2[cb] = *(const GAS bf16x8*)(B2 + (size_t)(32 * w + 16 * cb + n16) * 256 + 32 * ks + 8 * kq);
#pragma unroll
        for (int rb = 0; rb < 8; ++rb) { const LAS f32x4* hp = (const LAS f32x4*)(L + (16 * rb + n16) * S5_HSTR + (32 * ks + 8 * kq) * 4); const f32x4 lo = hp[0], hi = hp[1];
            v4u pk; pk.x = pk2(lo.x, lo.y); pk.y = pk2(lo.z, lo.w); pk.z = pk2(hi.x, hi.y); pk.w = pk2(hi.z, hi.w); const bf16x8 a = __builtin_bit_cast(bf16x8, pk);
#pragma unroll
            for (int cb = 0; cb < 2; ++cb) Y[rb][cb] = __builtin_amdgcn_mfma_f32_16x16x32_bf16(a, b2[cb], Y[rb][cb], 0, 0, 0); }
    }
#pragma unroll
    for (int rb = 0; rb < 8; ++rb)
#pragma unroll
        for (int cb = 0; cb < 2; ++cb)
        {
            const bool ev = (lane & 1) == 0; const int t = 2 * w + cb, c0 = g * 16 + (n16 & ~1);
            const float v0 = gelu_tanh_f(Y[rb][cb][0]), v1 = gelu_tanh_f(Y[rb][cb][1]), v2 = gelu_tanh_f(Y[rb][cb][2]), v3 = gelu_tanh_f(Y[rb][cb][3]);
            const float r0 = lx1(ev ? v2 : v0), r1 = lx1(ev ? v3 : v1);
            const float lo0 = ev ? v0 : r0, hi0 = ev ? r0 : v2, lo1 = ev ? v1 : r1, hi1 = ev ? r1 : v3;
            const size_t row0 = (size_t)(mbase + 16 * (16 * rb + 4 * kq + (ev ? 0 : 2)) + t) * SW + c0, row1 = row0 + (size_t)16 * SW;
            *(GAS unsigned*)(YS5 + row0) = pk2(lo0, hi0); *(GAS unsigned*)(YS5 + row1) = pk2(lo1, hi1);
            *(GAS unsigned short*)(YQ8 + row0) = (unsigned short)__builtin_amdgcn_cvt_pk_fp8_f32(__builtin_amdgcn_fmed3f(lo0 * YQ_S, -448.f, 448.f), __builtin_amdgcn_fmed3f(hi0 * YQ_S, -448.f, 448.f), 0, false);
            *(GAS unsigned short*)(YQ8 + row1) = (unsigned short)__builtin_amdgcn_cvt_pk_fp8_f32(__builtin_amdgcn_fmed3f(lo1 * YQ_S, -448.f, 448.f), __builtin_amdgcn_fmed3f(hi1 * YQ_S, -448.f, 448.f), 0, false); }
}

struct Args { const float* in[29]; float* out; unsigned char* ws; int ph_lo, ph_hi; };
static_assert(sizeof(Args) == 31 * 8 + 8, "Args has no padding");
#ifndef R6A
#define R6A 1
#endif
#ifndef R6B
#define R6B 1
#endif
#ifndef R7
#define R7 1
#endif
#ifndef PG8_SP2
#define PG8_SP2 true
#endif
#ifndef PG8_ALIGN
#define PG8_ALIGN true
#endif
struct MapOrder {
    pg8::StaticOrder S; int remap;
    __device__ __forceinline__ bool next(int i, pg8::Unit& u) const { if (!S.next(i, u)) return false; if (remap) u.pn = u.pn < 12 ? 4 + u.pn : 12 + u.pn; return true; }
    __device__ __forceinline__ void a_ready(const pg8::Unit&) const {}
    __device__ __forceinline__ void done(const pg8::Unit&) const {}
};
__global__ void __launch_bounds__(NWAVES * 64, 2) mk_fwd(Args args) {
    extern __shared__ __attribute__((aligned(16))) unsigned char lds[];
    Frame F;
    F.lds = (LAS unsigned char*)lds;
    F.MISC = (volatile LAS unsigned*)(F.lds + MISC_OFF);
    F.wave = __builtin_amdgcn_readfirstlane((int)threadIdx.x >> 6); F.lane = lane_now(); F.tid = F.wave * 64 + F.lane;
    F.G = gridDim.x; { const int bx = blockIdx.x; F.vcu = (F.G % 8 == 0) ? (bx % 8) * (F.G / 8) + bx / 8 : bx; }
    F.out = args.out; F.ws = args.ws; F.ctl = (gu32*)(args.ws + WS_CTL);
    if (F.tid < 32) ((LAS unsigned*)(F.lds + MISC_OFF))[F.tid] = 0u;
    if (F.tid < 29) *(LAS unsigned long long*)(F.lds + PTR_OFF + 8 * F.tid) = (unsigned long long)args.in[F.tid];
    __syncthreads();
    XcdBarrier bar; bar.bar = (unsigned*)(F.ctl + CW_BAR); bar.x = 0; bar.st = nullptr;
    if (!MK_PER_PHASE) bar = xcd_barrier_post((unsigned*)(F.ctl + CW_BAR), F.MISC + 8);
    const int lo = args.ph_lo, hi = args.ph_hi;
#define IN(k) (lo <= (k) && (k) < hi)
#ifndef MK_REP
#define MK_REP 0
#endif
#define REPS(k) (((MK_REP >> (k)) & 1) ? 2 : 1)
#define SEAM(k) do { if (IN(k) && IN((k) + 1)) xcd_barrier(bar); } while (0)
    bf16* const H = (bf16*)(F.ws + WS_H);

    if (IN(0)) _Pragma("unroll 1") for (int rep_ = 0; rep_ < REPS(0); ++rep_) { F.lane = lane_now(); F.tid = F.wave * 64 + F.lane; if (rep_) { VM_WAIT(); __syncthreads(); } p0_prologue(F); } SEAM(0);
    if (IN(1)) _Pragma("unroll 1") for (int rep_ = 0; rep_ < REPS(1); ++rep_) { F.lane = lane_now(); F.tid = F.wave * 64 + F.lane; if (rep_) { VM_WAIT(); __syncthreads(); } norm_phase<0>(F); } SEAM(1);
    if (IN(2)) _Pragma("unroll 1") for (int rep_ = 0; rep_ < REPS(2); ++rep_) { F.lane = lane_now(); F.tid = F.wave * 64 + F.lane; if (rep_) { VM_WAIT(); __syncthreads(); } pg8::Gemm g{H, (const bf16*)(F.ws + WS_WGU1), M, NGU, MK_FP8 ? D / 2 : D}; pg8::StaticOrder S; S.init(M, NGU, F.G, (int)blockIdx.x);
        pg8::EpiSwiGLU E{F.ws + WS_ACT, DFF, (const float*)(F.ws + WS_SA), (const float*)(F.ws + WS_SW) + 0 * NGU};
        pg8::gemm_phase<pg8::EpiSwiGLU, pg8::StaticOrder, PG8_ALIGN, PG8_SP2, 2>(F.lds + RING_OFF, g, S, E, F.wave); } SEAM(2);
    if (IN(3)) _Pragma("unroll 1") for (int rep_ = 0; rep_ < REPS(3); ++rep_) { F.lane = lane_now(); F.tid = F.wave * 64 + F.lane; if (rep_) { VM_WAIT(); __syncthreads(); } pg8::Gemm g{(const bf16*)(F.ws + WS_ACT), (const bf16*)(F.ws + WS_WDN1), M, D, DFF / 2}; pg8::StaticOrder S; S.init(M, D, F.G, (int)blockIdx.x);
        pg8::EpiBf16P E{(bf16*)(F.ws + WS_FFO), D};
        pg8::gemm_phase<pg8::EpiBf16P, pg8::StaticOrder, PG8_ALIGN, PG8_SP2, 1>(F.lds + RING_OFF, g, S, E, F.wave, 127 - 10, 127 - 2); } SEAM(3);
    if (IN(4)) _Pragma("unroll 1") for (int rep_ = 0; rep_ < REPS(4); ++rep_) { F.lane = lane_now(); F.tid = F.wave * 64 + F.lane; if (rep_) { VM_WAIT(); __syncthreads(); } norm_phase<1>(F); } SEAM(4);
    if (IN(5)) _Pragma("unroll 1") for (int rep_ = 0; rep_ < REPS(5); ++rep_) { F.lane = lane_now(); F.tid = F.wave * 64 + F.lane; if (rep_) { VM_WAIT(); __syncthreads(); }
        { pg8::Gemm g{H, (const bf16*)(F.ws + WS_WIN), M, NIN, D}; MapOrder S; S.S.init(M, 20 * 256, F.G, (int)blockIdx.x); S.remap = 1;
          pg8::EpiBf16P E{(bf16*)(F.ws + WS_PROJ), NIN};
          pg8::gemm_phase<pg8::EpiBf16P, MapOrder, PG8_ALIGN, PG8_SP2>(F.lds + RING_OFF, g, S, E, F.wave); }
        F.lane = lane_now(); F.tid = F.wave * 64 + F.lane;
        { pg8::Gemm g{(const bf16*)(F.ws + WS_ACT), (const bf16*)(F.ws + WS_WOUT + 16 * MiB), M, 12 * 256, D / 2}; MapOrder S; S.S.init(M, 12 * 256, F.G, ((int)blockIdx.x + (int)F.G / 2) % (int)F.G); S.remap = 0;
          pg8::EpiI8Bf16P E{(bf16*)(F.ws + WS_PROJ), NIN, (const float*)(F.ws + WS_SA), (const float*)(F.ws + WS_SW) + 2 * NGU + D, 4, 12};
          pg8::gemm_phase<pg8::EpiI8Bf16P, MapOrder, PG8_ALIGN, PG8_SP2, 2>(F.lds + RING_OFF, g, S, E, F.wave); }
        F.lane = lane_now(); F.tid = F.wave * 64 + F.lane;
        lr_mini_gemm(F); } SEAM(5);
    if (IN(6)) _Pragma("unroll 1") for (int rep_ = 0; rep_ < REPS(6); ++rep_) { F.lane = lane_now(); F.tid = F.wave * 64 + F.lane; if (rep_) { VM_WAIT(); __syncthreads(); }
        for (int u = blockIdx.x; u < 2048 * R6A; u += F.G) gla_prep_unit(F, u & 2047);
        for (int u = blockIdx.x; u < 512 * R6B; u += F.G) s5_unit(F, u & 127, (u >> 7) & 3);
    } SEAM(6);
    if (IN(7)) _Pragma("unroll 1") for (int rep_ = 0; rep_ < REPS(7); ++rep_) { F.lane = lane_now(); F.tid = F.wave * 64 + F.lane; if (rep_) { VM_WAIT(); __syncthreads(); }
        for (int u_ = blockIdx.x; u_ < 256 * R7; u_ += F.G) { const int u = u_ & 255;
            const int n_it = u < 128 ? 1 : 8;
            for (int e = 0; e < n_it; ++e) {
                int latent, b, h, d, vs; const float* S0; float* Sout;
                if (u < 128) { const int x = u & 7, j = u >> 3, grp = x + 8 * (j >> 2); latent = 1; vs = j & 3; b = grp >> 4; h = (grp >> 1) & 7; d = grp & 1;
                    S0 = inp(F, IN_SGLA) + ((size_t)(b * 2 + d) * 8 + h) * 32768; Sout = nullptr; }
                else { const int grp = (u - 128) * 2 + (e >> 2); latent = 0; vs = e & 3; b = grp >> 4; h = (grp >> 1) & 7; d = grp & 1;
                    S0 = nullptr; Sout = F.out + OUT_GLA + ((size_t)(b * 2 + d) * 8 + h) * 32768; }
                gla_scan_item(F, latent, b, h, d, vs, S0, Sout);
            }
        }
        F.lane = lane_now(); F.tid = F.wave * 64 + F.lane;
        { pg8::Gemm g{(const bf16*)(F.ws + WS_ACT), (const bf16*)(F.ws + WS_WGLU), M, SW, SW / 2}; pg8::StaticOrder S; S.init(M, SW, F.G, (int)blockIdx.x);
          pg8::EpiGlu E{(const bf16*)(F.ws + WS_YS5), SW, inp(F, IN_BGLU), (bf16*)(F.ws + WS_CAT), D, SW};
          pg8::gemm_phase<pg8::EpiGlu, pg8::StaticOrder, PG8_ALIGN, PG8_SP2, 1>(F.lds + RING_OFF, g, S, E, F.wave, 127 - 10, 127 - 3); }
    } SEAM(7);
    if (IN(8)) _Pragma("unroll 1") for (int rep_ = 0; rep_ < REPS(8); ++rep_) { F.lane = lane_now(); F.tid = F.wave * 64 + F.lane; if (rep_) { VM_WAIT(); __syncthreads(); }
        gla_post_phase(F); } SEAM(8);
    if (IN(9)) _Pragma("unroll 1") for (int rep_ = 0; rep_ < REPS(9); ++rep_) { F.lane = lane_now(); F.tid = F.wave * 64 + F.lane; if (rep_) { VM_WAIT(); __syncthreads(); } pg8::Gemm g{(const bf16*)(F.ws + WS_H), (const bf16*)(F.ws + WS_WOUT), M, D, D / 2}; pg8::StaticOrder S; S.init(M, D, F.G, (int)blockIdx.x);
        pg8::EpiI8Bf16P E{(bf16*)(F.ws + WS_FFO), D, (const float*)(F.ws + WS_SA), (const float*)(F.ws + WS_SW) + 2 * NGU, 1 << 30, 0};
        pg8::gemm_phase<pg8::EpiI8Bf16P, pg8::StaticOrder, PG8_ALIGN, PG8_SP2, 2>(F.lds + RING_OFF, g, S, E, F.wave); } SEAM(9);
    if (IN(10)) _Pragma("unroll 1") for (int rep_ = 0; rep_ < REPS(10); ++rep_) { F.lane = lane_now(); F.tid = F.wave * 64 + F.lane; if (rep_) { VM_WAIT(); __syncthreads(); } norm_phase<2>(F); } SEAM(10);
    if (IN(11)) _Pragma("unroll 1") for (int rep_ = 0; rep_ < REPS(11); ++rep_) { F.lane = lane_now(); F.tid = F.wave * 64 + F.lane; if (rep_) { VM_WAIT(); __syncthreads(); } pg8::Gemm g{H, (const bf16*)(F.ws + WS_WGU2), M, NGU, MK_FP8 ? D / 2 : D}; pg8::StaticOrder S; S.init(M, NGU, F.G, (int)blockIdx.x);
        pg8::EpiSwiGLU E{F.ws + WS_ACT, DFF, (const float*)(F.ws + WS_SA), (const float*)(F.ws + WS_SW) + 1 * NGU};
        pg8::gemm_phase<pg8::EpiSwiGLU, pg8::StaticOrder, PG8_ALIGN, PG8_SP2, 2>(F.lds + RING_OFF, g, S, E, F.wave); } SEAM(11);
    if (IN(12)) _Pragma("unroll 1") for (int rep_ = 0; rep_ < REPS(12); ++rep_) { F.lane = lane_now(); F.tid = F.wave * 64 + F.lane; if (rep_) { VM_WAIT(); __syncthreads(); } pg8::Gemm g{(const bf16*)(F.ws + WS_ACT), (const bf16*)(F.ws + WS_WDN2), M, D, DFF / 2}; pg8::StaticOrder S; S.init(M, D, F.G, (int)blockIdx.x);
        pg8::EpiBf16P E{(bf16*)(F.ws + WS_FFO), D};
        pg8::gemm_phase<pg8::EpiBf16P, pg8::StaticOrder, PG8_ALIGN, PG8_SP2, 1>(F.lds + RING_OFF, g, S, E, F.wave, 127 - 10, 127 - 2); } SEAM(12);
    if (IN(13)) _Pragma("unroll 1") for (int rep_ = 0; rep_ < REPS(13); ++rep_) { F.lane = lane_now(); F.tid = F.wave * 64 + F.lane; if (rep_) { VM_WAIT(); __syncthreads(); } norm_phase<3>(F); }
#ifdef XB_EXTRA
    _Pragma("unroll 1") for (int i_ = 0; i_ < XB_EXTRA; ++i_) xcd_barrier(bar);
#endif
#undef IN
#undef SEAM
}

extern "C" void kernel_launch(void* const* d_in, const int* in_sizes, int n_in, void* d_out, int out_size, void* d_ws, size_t ws_size, hipStream_t stream) {
    static int grid = 0;
    if (grid == 0) {
        if (n_in != 29 || out_size != (int)OUT_END || ws_size < WS_END) { fprintf(stderr, "kernel_launch: unexpected shapes (n_in %d, out %d, ws %zu; need ws >= %zu); nothing launched\n", n_in, out_size, ws_size, (size_t)WS_END); grid = -1; return; }
        int dev = 0, cus = 0, per_cu = 0;
        if (hipGetDevice(&dev) != hipSuccess || hipDeviceGetAttribute(&cus, hipDeviceAttributeMultiprocessorCount, dev) != hipSuccess) { grid = -1; return; }
        if (hipFuncSetAttribute((const void*)mk_fwd, hipFuncAttributeMaxDynamicSharedMemorySize, LDS_BYTES) != hipSuccess) { fprintf(stderr, "kernel_launch: hipFuncSetAttribute failed\n"); grid = -1; return; }
        if (hipOccupancyMaxActiveBlocksPerMultiprocessor(&per_cu, (const void*)mk_fwd, NWAVES * 64, LDS_BYTES) != hipSuccess || per_cu < 1) fprintf(stderr, "kernel_launch: occupancy query reports %d\n", per_cu);
        (void)hipGetLastError();
        grid = cus;
    }
    if (grid < 0) return;
    if (hipMemsetAsync((char*)d_ws + WS_CTL, 0, CTL_ZERO_BYTES, stream) != hipSuccess) { fprintf(stderr, "kernel_launch: memset failed\n"); return; }
    Args a{};
    for (int i = 0; i < 29; ++i) a.in[i] = (const float*)d_in[i];
    a.out = (float*)d_out; a.ws = (unsigned char*)d_ws;
#if MK_PER_PHASE
    for (int p = 0; p < NPH; ++p) { a.ph_lo = p; a.ph_hi = p + 1; hipLaunchKernelGGL(mk_fwd, dim3(grid), dim3(NWAVES * 64), LDS_BYTES, stream, a); }
#else
    a.ph_lo = 0; a.ph_hi = NPH; hipLaunchKernelGGL(mk_fwd, dim3(grid), dim3(NWAVES * 64), LDS_BYTES, stream, a);
#endif
    const hipError_t le = hipPeekAtLastError();
    if (le != hipSuccess) fprintf(stderr, "kernel_launch: launch failed: %s\n", hipGetErrorName(le));
}
```

```cpp
#include <hip/hip_runtime.h>
#include <cstdio>
#include <cstdint>
__device__ __forceinline__ int lane_now() { int l; asm volatile("v_mbcnt_lo_u32_b32 %0, -1, 0\n\tv_mbcnt_hi_u32_b32 %0, -1, %0" : "=v"(l)); return l; }
namespace pg8 {
#define PG8_LAS __attribute__((address_space(3)))
typedef unsigned short bf16_t;
typedef short bf16x8 __attribute__((ext_vector_type(8)));
typedef float f32x4 __attribute__((ext_vector_type(4)));
typedef unsigned u32x4 __attribute__((ext_vector_type(4)));
constexpr int BM = 256, BK = 64, HALF = 128, HTB = HALF * BK * 2  , STAGE_BYTES = 8 * HTB, NXCD = 8, WGM = 8;

__host__ __device__ __forceinline__ int lds_byte(int r, int c) { const int st = (r >> 4) * 2 + (c >> 5), rr = r & 15, cc = c & 31, ob = rr * 64 + cc * 2; return st * 1024 + (ob ^ (((ob >> 9) & 1) << 5)); }
__host__ __device__ __forceinline__ void stage_rc(int b, int& R, int& C) { const int st = b / 1024, sb = b % 1024, swz = sb ^ (((sb >> 9) & 1) << 5); R = (st >> 1) * 16 + swz / 64; C = (st & 1) * 32 + (swz % 64) / 2; }
__host__ __device__ __forceinline__ int perm32(int rho) { const int n = rho >> 4, i = rho & 15; return 8 * (i >> 2) + 4 * n + (i & 3); }

struct Unit { int pm, pn; };
struct Gemm { const bf16_t* A; const bf16_t* Bt; int M, N, K; };

struct StaticOrder {
    int nM, nN, nwg, G, c;
    __host__ __device__ void init(int M, int N, int G_, int c_) { nM = M / BM; nN = N / BM; nwg = nM * nN; G = G_; c = c_; }
    __host__ __device__ bool next(int i, Unit& u) const {
        const long L = (long)i * G + c; if (L >= nwg) return false;
        int wgid = (int)L; { const int q = nwg / NXCD, r = nwg % NXCD, xcd = wgid % NXCD, off = wgid / NXCD; wgid = (xcd < r ? xcd * (q + 1) : r * (q + 1) + (xcd - r) * q) + off; }
        const int nig = WGM * nN, gid = wgid / nig, fm = gid * WGM, gsz = (nM - fm) < WGM ? (nM - fm) : WGM;
        u.pm = fm + ((wgid % nig) % gsz); u.pn = (wgid % nig) / gsz; return true;
    }
    __device__ __forceinline__ void a_ready(const Unit&) const {}
    __device__ __forceinline__ void done(const Unit&) const {}
};

typedef __bf16 hbf16x2_t __attribute__((ext_vector_type(2))); typedef float f32x2_t __attribute__((ext_vector_type(2)));
__device__ __forceinline__ unsigned cvt_pk_bf16(float lo, float hi) { const f32x2_t v = {lo, hi}; return __builtin_bit_cast(unsigned, __builtin_convertvector(v, hbf16x2_t)); }
typedef float f32x2 __attribute__((ext_vector_type(2)));
typedef int i32x4 __attribute__((ext_vector_type(4)));
typedef int i32x8 __attribute__((ext_vector_type(8)));
typedef unsigned u32x2 __attribute__((ext_vector_type(2)));
template <int QT> struct AccOf { typedef f32x4 type; };
template <> struct AccOf<2> { typedef i32x4 type; };
__device__ __forceinline__ i32x8 cat8(bf16x8 lo, bf16x8 hi) { const i32x4 a = __builtin_bit_cast(i32x4, lo), b = __builtin_bit_cast(i32x4, hi); return __builtin_shufflevector(a, b, 0, 1, 2, 3, 4, 5, 6, 7); }
__device__ __forceinline__ float sigmoid_f(float z) { return __builtin_amdgcn_rcpf(1.0f + __expf(-z)); }
constexpr float ACT_Q = 4.0f;
struct EpiSwiGLU {
    static constexpr bool PERM = true, AFTER_DRAIN = false;
    unsigned char* O; int ldc; const float* sA; const float* sW;
    __device__ __forceinline__ void operator()(const i32x4 (&acc)[2][2][4][2], const Unit& u, int wr, int wc, int fr, int fq) const {
        const int row0 = u.pm * BM + wr * 64 + fr, col0 = u.pn * HALF + wc * 32 + 8 * fq, wrow0 = u.pn * BM + wc * 32 + 8 * fq;
        f32x4 sg[2], su[2];
#pragma unroll
        for (int n = 0; n < 2; ++n) { sg[n] = *(const f32x4*)(sW + wrow0 + 4 * n); su[n] = *(const f32x4*)(sW + wrow0 + HALF + 4 * n); }
#pragma unroll
        for (int ai = 0; ai < 2; ++ai)
#pragma unroll
            for (int m = 0; m < 4; ++m) { const int r = row0 + ai * HALF + m * 16; const float sa = sA[r];
                float o[8];
#pragma unroll
                for (int n = 0; n < 2; ++n)
#pragma unroll
                    for (int j = 0; j < 4; ++j) { const float g = (float)acc[ai][0][m][n][j] * (sa * sg[n][j]), up = (float)acc[ai][1][m][n][j] * (sa * su[n][j]);
                        o[4 * n + j] = __builtin_amdgcn_fmed3f(g * sigmoid_f(g) * up * ACT_Q, -448.0f, 448.0f); }
                int w0 = 0, w1 = 0; w0 = __builtin_amdgcn_cvt_pk_fp8_f32(o[0], o[1], w0, false); w0 = __builtin_amdgcn_cvt_pk_fp8_f32(o[2], o[3], w0, true); w1 = __builtin_amdgcn_cvt_pk_fp8_f32(o[4], o[5], w1, false); w1 = __builtin_amdgcn_cvt_pk_fp8_f32(o[6], o[7], w1, true);
                u32x2 w; w.x = (unsigned)w0; w.y = (unsigned)w1; *(u32x2*)(O + (size_t)r * ldc + col0) = w; }
    }
};
struct EpiF32 {
    static constexpr bool PERM = false, AFTER_DRAIN = false;
    float* C; int ldc;
    __device__ __forceinline__ void operator()(const f32x4 (&acc)[2][2][4][2], const Unit& u, int wr, int wc, int fr, int fq) const {
        const int row0 = u.pm * BM + wr * 64 + fr, col0 = u.pn * BM + wc * 32 + 4 * fq;
#pragma unroll
        for (int ai = 0; ai < 2; ++ai)
#pragma unroll
            for (int m = 0; m < 4; ++m) { float* rowp = C + (size_t)(row0 + ai * HALF + m * 16) * ldc + col0;
#pragma unroll
                for (int bj = 0; bj < 2; ++bj)
#pragma unroll
                    for (int n = 0; n < 2; ++n) *(f32x4*)(rowp + bj * HALF + n * 16) = acc[ai][bj][m][n]; }
    }
};
struct EpiBf16P {
    static constexpr bool PERM = true, AFTER_DRAIN = false;
    bf16_t* O; int ldc;
    __device__ __forceinline__ void operator()(const f32x4 (&acc)[2][2][4][2], const Unit& u, int wr, int wc, int fr, int fq) const {
        const int row0 = u.pm * BM + wr * 64 + fr, col0 = u.pn * BM + wc * 32 + 8 * fq;
#pragma unroll
        for (int ai = 0; ai < 2; ++ai)
#pragma unroll
            for (int m = 0; m < 4; ++m) { bf16_t* rowp = O + (size_t)(row0 + ai * HALF + m * 16) * ldc + col0;
#pragma unroll
                for (int bj = 0; bj < 2; ++bj) { const f32x4 v0 = acc[ai][bj][m][0], v1 = acc[ai][bj][m][1];
                    u32x4 w; w.x = cvt_pk_bf16(v0[0], v0[1]); w.y = cvt_pk_bf16(v0[2], v0[3]); w.z = cvt_pk_bf16(v1[0], v1[1]); w.w = cvt_pk_bf16(v1[2], v1[3]);
                    *(u32x4*)(rowp + bj * HALF) = w; } }
    }
};
struct EpiI8Bf16P {
    static constexpr bool PERM = true, AFTER_DRAIN = false;
    bf16_t* O; int ldc; const float* sA; const float* sW; int split, add;
    __device__ __forceinline__ void operator()(const i32x4 (&acc)[2][2][4][2], const Unit& u, int wr, int wc, int fr, int fq) const {
        const int row0 = u.pm * BM + wr * 64 + fr, col0 = u.pn * BM + wc * 32 + 8 * fq, ocol0 = (u.pn < split ? u.pn : u.pn + add) * BM + wc * 32 + 8 * fq;
        f32x4 sw[2][2];
#pragma unroll
        for (int bj = 0; bj < 2; ++bj)
#pragma unroll
            for (int n = 0; n < 2; ++n) sw[bj][n] = *(const f32x4*)(sW + col0 + bj * HALF + 4 * n);
#pragma unroll
        for (int ai = 0; ai < 2; ++ai)
#pragma unroll
            for (int m = 0; m < 4; ++m) { const int r = row0 + ai * HALF + m * 16; const float sa = sA[r]; bf16_t* rowp = O + (size_t)r * ldc + ocol0;
#pragma unroll
                for (int bj = 0; bj < 2; ++bj) { const i32x4 v0 = acc[ai][bj][m][0], v1 = acc[ai][bj][m][1]; const f32x4 s0 = sw[bj][0] * sa, s1 = sw[bj][1] * sa;
                    u32x4 w; w.x = cvt_pk_bf16((float)v0[0] * s0[0], (float)v0[1] * s0[1]); w.y = cvt_pk_bf16((float)v0[2] * s0[2], (float)v0[3] * s0[3]);
                    w.z = cvt_pk_bf16((float)v1[0] * s1[0], (float)v1[1] * s1[1]); w.w = cvt_pk_bf16((float)v1[2] * s1[2], (float)v1[3] * s1[3]);
                    *(u32x4*)(rowp + bj * HALF) = w; } }
    }
};
struct EpiGlu {
    static constexpr bool PERM = true, AFTER_DRAIN = false;
    const bf16_t* Y; int ldy; const float* bias; bf16_t* O; int ldc; int ocol0;
    __device__ __forceinline__ void operator()(const f32x4 (&acc)[2][2][4][2], const Unit& u, int wr, int wc, int fr, int fq) const {
        const int row0 = u.pm * BM + wr * 64 + fr, col0 = u.pn * BM + wc * 32 + 8 * fq;
        f32x4 bv[2][2];
#pragma unroll
        for (int bj = 0; bj < 2; ++bj)
#pragma unroll
            for (int n = 0; n < 2; ++n) bv[bj][n] = *(const f32x4*)(bias + col0 + bj * HALF + 4 * n);
#pragma unroll
        for (int ai = 0; ai < 2; ++ai)
#pragma unroll
            for (int m = 0; m < 4; ++m) { const size_t r = (size_t)(row0 + ai * HALF + m * 16);
#pragma unroll
                for (int bj = 0; bj < 2; ++bj) { const u32x4 yv = *(const u32x4*)(Y + r * ldy + col0 + bj * HALF);
                    const f32x4 z0 = acc[ai][bj][m][0] + bv[bj][0], z1 = acc[ai][bj][m][1] + bv[bj][1];
                    float o[8];
                    o[0] = __uint_as_float(yv.x << 16) * sigmoid_f(z0[0]); o[1] = __uint_as_float(yv.x & 0xffff0000u) * sigmoid_f(z0[1]);
                    o[2] = __uint_as_float(yv.y << 16) * sigmoid_f(z0[2]); o[3] = __uint_as_float(yv.y & 0xffff0000u) * sigmoid_f(z0[3]);
                    o[4] = __uint_as_float(yv.z << 16) * sigmoid_f(z1[0]); o[5] = __uint_as_float(yv.z & 0xffff0000u) * sigmoid_f(z1[1]);
                    o[6] = __uint_as_float(yv.w << 16) * sigmoid_f(z1[2]); o[7] = __uint_as_float(yv.w & 0xffff0000u) * sigmoid_f(z1[3]);
                    u32x4 w; w.x = cvt_pk_bf16(o[0], o[1]); w.y = cvt_pk_bf16(o[2], o[3]); w.z = cvt_pk_bf16(o[4], o[5]); w.w = cvt_pk_bf16(o[6], o[7]);
                    *(u32x4*)(O + r * ldc + ocol0 + col0 + bj * HALF) = w; } }
    }
};
template <class Epi, class Sched, bool ALIGN_EPI = false, bool SP2 = false, int QT = 0>
__device__ __forceinline__ void gemm_phase(PG8_LAS unsigned char* lds, const Gemm g, const Sched& S, const Epi& E, int wid_in, int sw = 127, int sa = 127) {
    const int wid = wid_in, lane = lane_now(), tid = wid * 64 + lane, wr = wid >> 2, wc = wid & 3, fr = lane & 15, fq = lane >> 4;
    const int K = g.K, nt = K / BK;
    unsigned voffA[2], voffB[2];
#pragma unroll
    for (int i = 0; i < 2; ++i) { int R, C; stage_rc(tid * 16 + i * 8192, R, C); const int Rb = Epi::PERM ? ((R & ~31) + perm32(R & 31)) : R;
        voffA[i] = (unsigned)(R * K + C) * 2u; voffB[i] = (unsigned)(Rb * K + C) * 2u; }
    const unsigned kstep = (unsigned)(BK * 2);
    const unsigned hstep = (unsigned)HALF * (unsigned)K * 2u;
    const unsigned tstep = 2u * hstep;
    const unsigned ldsw = (unsigned)wid * 1024u;
    const int aoff = lds_byte(wr * 64 + fr, fq * 8), boff = lds_byte(wc * 32 + fr, fq * 8);
#define PG8_SA(b, h) (((b) * 2 + (h)) * HTB)
#define PG8_SB(b, h) ((4 + (b) * 2 + (h)) * HTB)
    const __amdgpu_buffer_rsrc_t rsrc_voffA = __builtin_amdgcn_make_buffer_rsrc((void*)g.A, 0, (int)((unsigned)g.M * (unsigned)K * 2u), 0x00020000);
    const __amdgpu_buffer_rsrc_t rsrc_voffB = __builtin_amdgcn_make_buffer_rsrc((void*)g.Bt, 0, (int)((unsigned)g.N * (unsigned)K * 2u), 0x00020000);
#define PG8_STAGE(bufoff, goff, voff) do { _Pragma("unroll") for (int _i = 0; _i < 2; ++_i) \
        __builtin_amdgcn_raw_ptr_buffer_load_lds(rsrc_##voff, (PG8_LAS void*)(lds + (bufoff) + ldsw + _i * 8192), 16, (int)(voff)[_i], (int)(goff), 0, 0); } while (0)
#define PG8_LDA(dst, b, h) do { _Pragma("unroll") for (int m = 0; m < 4; ++m) _Pragma("unroll") for (int k = 0; k < 2; ++k) dst[m][k] = *(const PG8_LAS bf16x8*)(lds + PG8_SA(b, h) + aoff + m * 2048 + k * 1024); } while (0)
#define PG8_LDB(dst, b, h) do { _Pragma("unroll") for (int n = 0; n < 2; ++n) _Pragma("unroll") for (int k = 0; k < 2; ++k) dst[n][k] = *(const PG8_LAS bf16x8*)(lds + PG8_SB(b, h) + boff + n * 2048 + k * 1024); } while (0)
#define PG8_MMA(ai, bj, At, Bt) do { __builtin_amdgcn_s_setprio(1); _Pragma("unroll") for (int m = 0; m < 4; ++m) _Pragma("unroll") for (int n = 0; n < 2; ++n) { \
        if constexpr (QT == 1) acc[ai][bj][m][n] = __builtin_amdgcn_mfma_scale_f32_16x16x128_f8f6f4(cat8(Bt[n][0], Bt[n][1]), cat8(At[m][0], At[m][1]), acc[ai][bj][m][n], 0, 0, 0, sw, 0, sa); \
        else if constexpr (QT == 2) { _Pragma("unroll") for (int k = 0; k < 2; ++k) acc[ai][bj][m][n] = __builtin_amdgcn_mfma_i32_16x16x64_i8(__builtin_bit_cast(i32x4, Bt[n][k]), __builtin_bit_cast(i32x4, At[m][k]), acc[ai][bj][m][n], 0, 0, 0); } \
        else { _Pragma("unroll") for (int k = 0; k < 2; ++k) acc[ai][bj][m][n] = __builtin_amdgcn_mfma_f32_16x16x32_bf16(Bt[n][k], At[m][k], acc[ai][bj][m][n], 0, 0, 0); } } __builtin_amdgcn_s_setprio(0); } while (0)
#define PG8_WAIT_V(n) asm volatile("s_waitcnt vmcnt(" #n ")" ::: "memory")
#define PG8_WAIT_L(n) asm volatile("s_waitcnt lgkmcnt(" #n ")" ::: "memory")
#define PG8_BAR __builtin_amdgcn_s_barrier()
#define PG8_SCHED __builtin_amdgcn_sched_barrier(0)
    Unit cur, nxt; int ui = 0;
    if (!S.next(0, cur)) return;
    typedef typename AccOf<QT>::type acc_t;
    acc_t acc[2][2][4][2];
#pragma unroll
    for (int a = 0; a < 2; ++a)
#pragma unroll
        for (int b = 0; b < 2; ++b)
#pragma unroll
            for (int m = 0; m < 4; ++m)
#pragma unroll
                for (int n = 0; n < 2; ++n) acc[a][b][m][n] = acc_t{};
    bf16x8 At[4][2], B0[2][2], B1[2][2];
    unsigned cA = (unsigned)cur.pm * tstep, cB = (unsigned)cur.pn * tstep;
    S.a_ready(cur);
    if constexpr (SP2) {
        PG8_STAGE(PG8_SB(0, 0), cB, voffB); PG8_STAGE(PG8_SB(0, 1), cB + hstep, voffB); PG8_STAGE(PG8_SA(0, 0), cA, voffA); PG8_STAGE(PG8_SA(0, 1), cA + hstep, voffA);
        if (wr == 1) PG8_BAR;
        PG8_WAIT_V(2); PG8_BAR;
        PG8_STAGE(PG8_SB(1, 0), cB + kstep, voffB); PG8_STAGE(PG8_SA(1, 0), cA + kstep, voffA); PG8_STAGE(PG8_SB(1, 1), cB + hstep + kstep, voffB);
        PG8_WAIT_V(6); PG8_BAR;
    } else {
        PG8_STAGE(PG8_SB(0, 0), cB, voffB); PG8_STAGE(PG8_SA(0, 0), cA, voffA); PG8_STAGE(PG8_SB(0, 1), cB + hstep, voffB); PG8_STAGE(PG8_SA(0, 1), cA + hstep, voffA);
        if (wr == 1) PG8_BAR;
        PG8_WAIT_V(4); PG8_BAR;
        PG8_STAGE(PG8_SB(1, 0), cB + kstep, voffB); PG8_STAGE(PG8_SA(1, 0), cA + kstep, voffA); PG8_STAGE(PG8_SB(1, 1), cB + hstep + kstep, voffB);
        PG8_WAIT_V(6); PG8_BAR;
    }
    for (;;) {
        const bool has_next = S.next(ui + 1, nxt);
        const unsigned nA = has_next ? (unsigned)nxt.pm * tstep : cA, nB = has_next ? (unsigned)nxt.pn * tstep : cB;
        for (int t = 0; t < nt; t += 2) {
            const bool last = (t == nt - 2);
            const unsigned a1 = cA + (unsigned)(t + 1) * kstep;
            const unsigned a2 = last ? nA : cA + (unsigned)(t + 2) * kstep, b2 = last ? nB : cB + (unsigned)(t + 2) * kstep;
            const unsigned a3 = a2 + kstep, b3 = b2 + kstep;
            if (last && has_next) S.a_ready(nxt);
            if constexpr (SP2) {
            PG8_LDB(B0, 0, 0); PG8_LDB(B1, 0, 1); PG8_SCHED; PG8_LDA(At, 0, 0); PG8_STAGE(PG8_SA(1, 1), a1 + hstep, voffA);
            PG8_WAIT_V(8); PG8_WAIT_L(0); PG8_BAR; PG8_MMA(0, 0, At, B0); PG8_MMA(0, 1, At, B1); PG8_BAR; PG8_SCHED;
            PG8_LDA(At, 0, 1); PG8_STAGE(PG8_SB(0, 0), b2, voffB); PG8_STAGE(PG8_SB(0, 1), b2 + hstep, voffB); PG8_STAGE(PG8_SA(0, 0), a2, voffA);
            PG8_WAIT_V(8); PG8_WAIT_L(0); PG8_BAR; PG8_MMA(1, 0, At, B0); PG8_MMA(1, 1, At, B1); PG8_BAR; PG8_SCHED;
            PG8_LDB(B0, 1, 0); PG8_LDB(B1, 1, 1); PG8_SCHED; PG8_LDA(At, 1, 0); PG8_STAGE(PG8_SA(0, 1), a2 + hstep, voffA);
            PG8_WAIT_V(8); PG8_WAIT_L(0); PG8_BAR; PG8_MMA(0, 0, At, B0); PG8_MMA(0, 1, At, B1); PG8_BAR; PG8_SCHED;
            PG8_LDA(At, 1, 1); PG8_STAGE(PG8_SB(1, 0), b3, voffB); PG8_STAGE(PG8_SB(1, 1), b3 + hstep, voffB); PG8_STAGE(PG8_SA(1, 0), a3, voffA);
            PG8_WAIT_V(8); PG8_WAIT_L(0); PG8_BAR; PG8_MMA(1, 0, At, B0); PG8_MMA(1, 1, At, B1); PG8_BAR; PG8_SCHED;
            } else {
            PG8_LDB(B0, 0, 0); PG8_SCHED; PG8_LDA(At, 0, 0); PG8_STAGE(PG8_SA(1, 1), a1 + hstep, voffA);
            PG8_WAIT_L(8); PG8_BAR; PG8_WAIT_L(0); PG8_MMA(0, 0, At, B0); PG8_BAR; PG8_SCHED;
            PG8_LDB(B1, 0, 1); PG8_STAGE(PG8_SB(0, 0), b2, voffB);
            PG8_BAR; PG8_WAIT_L(0); PG8_MMA(0, 1, At, B1); PG8_BAR;
            PG8_LDA(At, 0, 1); PG8_STAGE(PG8_SA(0, 0), a2, voffA);
            PG8_BAR; PG8_WAIT_L(0); PG8_MMA(1, 0, At, B0); PG8_BAR; PG8_SCHED;
            PG8_STAGE(PG8_SB(0, 1), b2 + hstep, voffB);
            PG8_WAIT_V(6); PG8_BAR; PG8_MMA(1, 1, At, B1); PG8_BAR;
            PG8_LDB(B0, 1, 0); PG8_SCHED; PG8_LDA(At, 1, 0); PG8_STAGE(PG8_SA(0, 1), a2 + hstep, voffA);
            PG8_WAIT_L(8); PG8_BAR; PG8_WAIT_L(0); PG8_MMA(0, 0, At, B0); PG8_BAR; PG8_SCHED;
            PG8_LDB(B1, 1, 1); PG8_STAGE(PG8_SB(1, 0), b3, voffB);
            PG8_BAR; PG8_WAIT_L(0); PG8_MMA(0, 1, At, B1); PG8_BAR;
            PG8_LDA(At, 1, 1); PG8_STAGE(PG8_SA(1, 0), a3, voffA);
            PG8_BAR; PG8_WAIT_L(0); PG8_MMA(1, 0, At, B0); PG8_BAR; PG8_SCHED;
            PG8_STAGE(PG8_SB(1, 1), b3 + hstep, voffB);
            PG8_WAIT_V(6); PG8_BAR; PG8_MMA(1, 1, At, B1); PG8_BAR;
            }
        }
        if constexpr (ALIGN_EPI) { if (wr == 0) PG8_BAR; }
        if constexpr (!Epi::AFTER_DRAIN) { E(acc, cur, wr, wc, fr, fq); S.done(cur); }
        if (!has_next) break;
#pragma unroll
        for (int a = 0; a < 2; ++a)
#pragma unroll
            for (int b = 0; b < 2; ++b)
#pragma unroll
                for (int m = 0; m < 4; ++m)
#pragma unroll
                    for (int n = 0; n < 2; ++n) acc[a][b][m][n] = acc_t{};
        cur = nxt; cA = nA; cB = nB; ++ui;
        if constexpr (ALIGN_EPI) { if (wr == 1) PG8_BAR; }
    }
    PG8_WAIT_V(0);
    if constexpr (!ALIGN_EPI) { if (wr == 0) PG8_BAR; }
    PG8_BAR;
    if constexpr (Epi::AFTER_DRAIN) { E.fused(acc, cur, wr, wc, fr, fq, lds, wid, lane); S.done(cur); }
#undef PG8_SA
#undef PG8_SB
#undef PG8_STAGE
#undef PG8_LDA
#undef PG8_LDB
#undef PG8_MMA
#undef PG8_WAIT_V
#undef PG8_WAIT_L
#undef PG8_BAR
#undef PG8_SCHED
}
}

constexpr int NWAVES = 8;
constexpr int D = 4096, M = 8192, MP = 4096, DFF = 11008, NGU = 2 * DFF, NIN = 8192, SW = 2048;
constexpr int NMODC = 9 * D;
constexpr int D_IN_SRC = 8224;
constexpr float EPS = 1e-6f;
constexpr int NPH = 14;
#ifndef MK_FP8
#define MK_FP8 1
#endif
#ifndef MK_PER_PHASE
#define MK_PER_PHASE 0
#endif
constexpr int PJ_Q = 0, PJ_K = 1024, PJ_V = 2048, PJ_G = 4096, PJ_U = 6144;
constexpr size_t OUT_Y = 0, OUT_GLA = (size_t)M * D, OUT_S5R = OUT_GLA + (size_t)16 * 2 * 8 * 128 * 256, OUT_S5I = OUT_S5R + 16 * 2 * 128 * 64, OUT_END = OUT_S5I + 16 * 2 * 128 * 64;
constexpr size_t MiB = 1u << 20;
constexpr size_t WS_CTL = 0, CTL_ZERO_BYTES = 1 * MiB;
constexpr size_t WS_WGU1 = 1 * MiB;
constexpr size_t WS_WDN1 = WS_WGU1 + 172 * MiB;
constexpr size_t WS_WIN = WS_WDN1 + 86 * MiB;
constexpr size_t WS_WLR = WS_WIN + 64 * MiB;
constexpr size_t WS_WGLU = WS_WLR + 1 * MiB;
constexpr size_t WS_WOUT = WS_WGLU + 8 * MiB;
constexpr size_t WS_WGU2 = WS_WOUT + 32 * MiB;
constexpr size_t WS_WDN2 = WS_WGU2 + 172 * MiB;
constexpr size_t WS_S5B1 = WS_WDN2 + 86 * MiB;
constexpr size_t WS_S5B2 = WS_S5B1 + 32 * MiB;
constexpr size_t WS_MOD = WS_S5B2 + 16 * MiB;
constexpr size_t WS_ROPE = WS_MOD + 1 * MiB;
constexpr size_t WS_A16 = WS_ROPE + 65536;
constexpr size_t WS_SA = WS_ROPE + 262144;
constexpr size_t WS_SW = WS_ROPE + 327680;
constexpr size_t WS_H = WS_ROPE + 1 * MiB;
constexpr size_t WS_ACT = WS_H + 64 * MiB;
constexpr size_t WS_FFO = WS_ACT + 172 * MiB;
constexpr size_t WS_X1 = WS_FFO + 128 * MiB;
constexpr size_t WS_PROJ = WS_X1 + 128 * MiB;
constexpr size_t WS_LR = WS_PROJ + 128 * MiB;
constexpr size_t WS_OF = WS_LR + 1 * MiB;
constexpr size_t WS_OB = WS_OF + 64 * MiB;
constexpr size_t WS_YS5 = WS_OB + 64 * MiB;
constexpr size_t WS_CAT = WS_YS5 + 32 * MiB;
constexpr size_t WS_GLAW = WS_CAT + 64 * MiB;
constexpr size_t WS_VTW = WS_GLAW + 90 * MiB;
constexpr size_t WS_MODP = WS_VTW + 36 * MiB;
constexpr size_t WS_END = WS_MODP + 2 * MiB;
static_assert((size_t)NGU * D * 2 <= 172 * MiB && (size_t)D * DFF * 2 <= 86 * MiB && (size_t)M * DFF * 2 <= 172 * MiB, "ws map");
constexpr int CW_TMO = 0, CW_QUEUE = 1024, CW_BAR = 4096;
constexpr int LDS_BYTES = 163840;
constexpr int MISC_OFF = LDS_BYTES - 128;
constexpr int RING_OFF = 0;

#define GAS __attribute__((address_space(1)))
#define LAS __attribute__((address_space(3)))
typedef unsigned short bf16;
typedef unsigned v4u __attribute__((ext_vector_type(4)));
typedef unsigned v2u __attribute__((ext_vector_type(2)));
typedef float f32x4 __attribute__((ext_vector_type(4)));
typedef float f32x2 __attribute__((ext_vector_type(2)));
typedef float f32x16 __attribute__((ext_vector_type(16)));
typedef short bf16x8 __attribute__((ext_vector_type(8)));
typedef GAS unsigned gu32;
#define RLX_AGENT __ATOMIC_RELAXED, __HIP_MEMORY_SCOPE_AGENT
#define LDS_WAIT() asm volatile("s_waitcnt lgkmcnt(0)" ::: "memory")
#define VM_WAIT() asm volatile("s_waitcnt vmcnt(0)" ::: "memory")
typedef __bf16 hbf16x2 __attribute__((ext_vector_type(2)));
__device__ __forceinline__ unsigned pk2(float lo, float hi) { const f32x2 v = {lo, hi}; return __builtin_bit_cast(unsigned, __builtin_convertvector(v, hbf16x2)); }
__device__ __forceinline__ unsigned f2bf(float f) { return (unsigned)__builtin_bit_cast(unsigned short, (__bf16)f); }
__device__ __forceinline__ float bf2f(unsigned short b) { return __uint_as_float(((unsigned)b) << 16); }
__device__ __forceinline__ float bflo(unsigned w) { return __uint_as_float(w << 16); }
__device__ __forceinline__ float bfhi(unsigned w) { return __uint_as_float(w & 0xffff0000u); }
__device__ __forceinline__ float wave_sum(float v) {
#pragma unroll
    for (int o = 1; o < 64; o <<= 1) v += __shfl_xor(v, o);
    return v;
}
#define XB_TMO      128
#define XB_XCNT(j)  (256  + 64 * (j))
#define XB_XSUB(j)  (1280 + 64 * (j))
#define XB_XGEN(j)  (2304 + 64 * (j))
#define XB_TOP      3328
#define XB_TOPGEN   3392
#define XCD_BAR_WORDS 3456
#define XB_SPIN_CAP (1u << 18)

__device__ __forceinline__ unsigned xb_ld(unsigned* p)              { return __hip_atomic_load(p, __ATOMIC_RELAXED, __HIP_MEMORY_SCOPE_AGENT); }
__device__ __forceinline__ unsigned xb_add(unsigned* p, unsigned v) { return __hip_atomic_fetch_add(p, v, __ATOMIC_RELAXED, __HIP_MEMORY_SCOPE_AGENT); }
__device__ __forceinline__ unsigned xb_xcc_id() { return (unsigned)__builtin_amdgcn_s_getreg((3 << 11) | 20) & 0xFu; }
#define XB_SPIN(cond, bar) do { unsigned _sp = 0; while (cond) { __builtin_amdgcn_s_sleep(1); \
    if ((++_sp & 255u) == 0u) { if (xb_ld(&(bar)[XB_TMO])) break; if (_sp > XB_SPIN_CAP) { atomicAdd(&(bar)[XB_TMO], 1u); break; } } } } while (0)

struct XcdBarrier {
    unsigned* bar; unsigned x;
    volatile LAS unsigned* st;
};

__device__ __forceinline__ XcdBarrier xcd_barrier_post(unsigned* bar, volatile LAS unsigned* st) {
    XcdBarrier b; b.bar = bar; b.x = xb_xcc_id(); b.st = st;
    if (threadIdx.x == 0) (void)xb_add(&bar[XB_XCNT(b.x)], 1u);
    return b;
}
__device__ __forceinline__ void xcd_barrier_complete(unsigned* bar, unsigned x, unsigned& nloc, unsigned& nx) {
    const unsigned G = gridDim.x * gridDim.y * gridDim.z;
    unsigned sum, cnt, mine, sp = 0u;
    for (;;) {
        sum = 0u; cnt = 0u; mine = 0u;
#pragma unroll
        for (unsigned j = 0; j < 16; ++j) { const unsigned c = xb_ld(&bar[XB_XCNT(j)]); sum += c; cnt += (c > 0u) ? 1u : 0u; mine = (j == x) ? c : mine; }
        if (sum == G) break;
        __builtin_amdgcn_s_sleep(1);
        if ((++sp & 255u) == 0u) { if (xb_ld(&bar[XB_TMO])) break; if (sp > XB_SPIN_CAP) { atomicAdd(&bar[XB_TMO], 1u); break; } }
    }
    nloc = mine > 0u ? mine : 1u; nx = cnt > 0u ? cnt : 1u;
}

__device__ __forceinline__ void xcd_barrier(const XcdBarrier& b) {
    asm volatile("s_waitcnt vmcnt(0)" ::: "memory");
    __syncthreads();
    if (threadIdx.x == 0) {
        unsigned* bar = b.bar;
        __builtin_amdgcn_s_waitcnt(0);
        unsigned nloc = b.st[0], nx = b.st[1];
        if (nloc == 0u) { xcd_barrier_complete(bar, b.x, nloc, nx); b.st[0] = nloc; b.st[1] = nx; }
        const unsigned old = xb_add(&bar[XB_XSUB(b.x)], 1u);
        const unsigned gen = old / nloc;
        if (old + 1u == (gen + 1u) * nloc) {
            __builtin_amdgcn_fence(__ATOMIC_RELEASE, "agent");
            asm volatile("s_waitcnt vmcnt(0)" ::: "memory");
            const unsigned og = xb_add(&bar[XB_TOP], 1u);
            const unsigned tg = og / nx;
            if (og + 1u == (tg + 1u) * nx) xb_add(&bar[XB_TOPGEN], 1u);
            else XB_SPIN(xb_ld(&bar[XB_TOPGEN]) == tg, bar);
            __builtin_amdgcn_fence(__ATOMIC_ACQUIRE, "agent");
            xb_add(&bar[XB_XGEN(b.x)], 1u);
            asm volatile("s_waitcnt vmcnt(0)" ::: "memory");
        } else {
            XB_SPIN(xb_ld(&bar[XB_XGEN(b.x)]) == gen, bar);
            __builtin_amdgcn_fence(__ATOMIC_ACQUIRE, "agent");
            asm volatile("s_waitcnt vmcnt(0)" ::: "memory");
        }
    }
    __syncthreads();
}

struct Frame {
    LAS unsigned char* lds;
    volatile LAS unsigned* MISC;
    gu32* ctl;
    int tid, lane, wave;
    int vcu, G;
    float* out;
    unsigned char* ws;
};
constexpr int PTR_OFF = LDS_BYTES - 512;
__device__ __forceinline__ const float* inp(const Frame& F, int i) { const v2u p = *(const LAS v2u*)(F.lds + PTR_OFF + 8 * i);
    const unsigned long long a = ((unsigned long long)(unsigned)__builtin_amdgcn_readfirstlane((int)p.y) << 32) | (unsigned)__builtin_amdgcn_readfirstlane((int)p.x); return (const float*)a; }
#define IN_XP 0
#define IN_XS 1
#define IN_C 2
#define IN_SGLA 3
#define IN_SS5R 4
#define IN_SS5I 5
#define IN_CCTX 6
#define IN_WADA 7
#define IN_BADA 8
#define IN_NORMW 9
#define IN_WGU1 10
#define IN_WDN1 11
#define IN_WIN 12
#define IN_WGATE 13
#define IN_BGATE 14
#define IN_GNW 15
#define IN_LAMR 16
#define IN_LAMI 17
#define IN_LOGDT 18
#define IN_BRE 19
#define IN_BIM 20
#define IN_CRE 21
#define IN_CIM 22
#define IN_DSKIP 23
#define IN_WGLU 24
#define IN_BGLU 25
#define IN_WOUT 26
#define IN_WGU2 27
#define IN_WDN2 28
__device__ __forceinline__ const float* xrow(const Frame& F, int m) { return m < MP ? inp(F, IN_XP) + (size_t)m * D : inp(F, IN_XS) + (size_t)(m - MP) * D; }
__device__ __forceinline__ int mod_idx(int m) { return m < MP ? 0 : 1 + ((m - MP) >> 11); }

struct TrDesc { const float* src; unsigned char* dst; int ldw, K; bool valid, fp8; };
constexpr int TR_I_GU = 64 * 344, TR_I_DN = 172 * 64, TR_I_IN = 64 * 129, TR_I_GLU = 32 * 32, TR_I_OUT = 64 * 64;
constexpr int TR_NITEMS = 2 * TR_I_DN + TR_I_IN + TR_I_GLU;
__device__ __forceinline__ TrDesc tr_decode(const Frame& F, int it, int lane) {
    TrDesc d; d.valid = false; d.fp8 = false; d.src = nullptr; d.dst = nullptr; d.ldw = 0; d.K = 0;
    if (it >= TR_NITEMS) return d;
    int r = it, src_col, dst_row, k0, nvalid = 64, K, ldw; const float* W; bf16* WT; bool fp8 = false;
    if (r < 2 * TR_I_DN) { const int which = r >= TR_I_DN; if (which) r -= TR_I_DN; const int nb = r & 63, kb = r >> 6;
        src_col = 64 * nb; dst_row = 64 * nb; k0 = 64 * kb; K = DFF; ldw = D; W = inp(F, which ? IN_WDN2 : IN_WDN1); WT = (bf16*)(F.ws + (which ? WS_WDN2 : WS_WDN1)); fp8 = true; }
    else if ((r -= 2 * TR_I_DN) < TR_I_IN) { const int nb = r % 129, kb = r / 129; k0 = 64 * kb; K = D; ldw = D_IN_SRC; W = inp(F, IN_WIN);
        if (nb < 96) { src_col = 64 * nb; dst_row = 64 * nb; WT = (bf16*)(F.ws + WS_WIN); if (nb < 16 || nb >= 64) nvalid = 0; }
        else if (nb < 128) { src_col = 6176 + 64 * (nb - 96); dst_row = 64 * nb; WT = (bf16*)(F.ws + WS_WIN); }
        else { src_col = 6144; dst_row = 0; WT = (bf16*)(F.ws + WS_WLR); nvalid = 32; } }
    else if ((r -= TR_I_IN) < TR_I_GLU) { const int nb = r & 31, kb = r >> 5; src_col = 64 * nb; dst_row = 64 * nb; k0 = 64 * kb; K = SW; ldw = SW; W = inp(F, IN_WGLU); WT = (bf16*)(F.ws + WS_WGLU); fp8 = true; }
    else { r -= TR_I_GLU; const int nb = r & 63, kb = r >> 6; src_col = 64 * nb; dst_row = 64 * nb; k0 = 64 * kb; K = D; ldw = D; W = inp(F, IN_WOUT); WT = (bf16*)(F.ws + WS_WOUT); }
    d.ldw = ldw; d.fp8 = fp8;
    if (fp8) { const int kc = lane & 3, nq = lane >> 2; d.valid = true; d.K = K;
        d.src = W + (size_t)(k0 + 16 * kc) * ldw + src_col + 4 * nq; d.dst = (unsigned char*)WT + (size_t)(dst_row + 4 * nq) * K + k0 + 16 * kc; }
    else { const int kc = lane & 7, nq = lane >> 3; d.valid = 8 * nq < nvalid; d.K = 2 * K;
        d.src = W + (size_t)(k0 + 8 * kc) * ldw + src_col + 8 * nq; d.dst = (unsigned char*)(WT + (size_t)(dst_row + 8 * nq) * K + k0 + 8 * kc); }
    return d;
}
constexpr float WDN_Q = 1024.0f;
__device__ __forceinline__ float q8(float w) { return __builtin_amdgcn_fmed3f(w * WDN_Q, -448.0f, 448.0f); }
__device__ __forceinline__ void tr_load(const TrDesc& d, f32x4 (&a)[16]) {
    if (d.valid) {
        if (d.fp8) {
#pragma unroll
            for (int i = 0; i < 16; ++i) a[i] = *(const GAS f32x4*)(d.src + (size_t)i * d.ldw);
        } else {
#pragma unroll
            for (int i = 0; i < 8; ++i) { a[2 * i] = *(const GAS f32x4*)(d.src + (size_t)i * d.ldw); a[2 * i + 1] = *(const GAS f32x4*)(d.src + (size_t)i * d.ldw + 4); }
        }
    }
}
__device__ __forceinline__ void tr_store(const TrDesc& d, const f32x4 (&a)[16]) {
    if (d.valid) {
        if (d.fp8) {
#pragma unroll
            for (int j = 0; j < 4; ++j) { int w[4];
#pragma unroll
                for (int t = 0; t < 4; ++t) { int x = 0; x = __builtin_amdgcn_cvt_pk_fp8_f32(q8(a[4 * t][j]), q8(a[4 * t + 1][j]), x, false); x = __builtin_amdgcn_cvt_pk_fp8_f32(q8(a[4 * t + 2][j]), q8(a[4 * t + 3][j]), x, true); w[t] = x; }
                v4u o; o.x = (unsigned)w[0]; o.y = (unsigned)w[1]; o.z = (unsigned)w[2]; o.w = (unsigned)w[3];
                *(GAS v4u*)(d.dst + (size_t)j * d.K) = o; }
        } else {
#pragma unroll
            for (int j = 0; j < 8; ++j) { const int h = j >> 2, e = j & 3; v4u o; o.x = pk2(a[0 + h][e], a[2 + h][e]); o.y = pk2(a[4 + h][e], a[6 + h][e]); o.z = pk2(a[8 + h][e], a[10 + h][e]); o.w = pk2(a[12 + h][e], a[14 + h][e]);
                *(GAS v4u*)(d.dst + (size_t)j * d.K) = o; }
        }
    }
}
__device__ __forceinline__ void s5_prep(Frame& F, int g) {
    LAS float* T = (LAS float*)(F.lds + 49152);
    LAS float* APR = T;
    LAS float* API = APR + 2 * 17 * 64;
    LAS float* BBR = API + 2 * 17 * 64;
    LAS float* BBI = BBR + 2048;
    LAS float* CR = BBI + 2048;
    LAS float* CI = CR + 2048;
    LAS float* FR = CI + 2048;
    LAS float* FI = FR + 128;
    LAS float* KF = FI + 128;
    LAS float* CTR = KF + 8192;
    LAS float* CTI = CTR + 2048;
    const int tid = F.tid;
    if (tid < 128) {
        const int dir = tid >> 6, p = tid & 63;
        const double lr = (double)inp(F, IN_LAMR)[(dir * 128 + g) * 64 + p], li = (double)inp(F, IN_LAMI)[(dir * 128 + g) * 64 + p];
        const double dt = exp((double)inp(F, IN_LOGDT)[dir * 128 + g]);
        const double mag = exp(lr * dt), ar = mag * cos(li * dt), ai = mag * sin(li * dt);
        const double den = lr * lr + li * li;
        FR[tid] = (float)(((ar - 1.0) * lr + ai * li) / den); FI[tid] = (float)((ai * lr - (ar - 1.0) * li) / den);
        double pr = 1.0, pi = 0.0;
        for (int t = 0; t <= 16; ++t) { APR[(dir * 17 + t) * 64 + p] = (float)pr; API[(dir * 17 + t) * 64 + p] = (float)pi;
            if (t == 16) { float* a16 = (float*)(F.ws + WS_A16) + ((g * 2 + dir) * 64 + p) * 2; a16[0] = (float)pr; a16[1] = (float)pi; }
            const double nr = pr * ar - pi * ai, ni = pr * ai + pi * ar; pr = nr; pi = ni; }
    } else {
        for (int i = tid - 128; i < 2048; i += 384) { const int dir = i >> 10, cc = (i >> 6) & 15, pp = i & 63;
            const float cr = inp(F, IN_CRE)[((dir * 128 + g) * 16 + cc) * 64 + pp], ci = inp(F, IN_CIM)[((dir * 128 + g) * 16 + cc) * 64 + pp];
            CR[i] = cr; CI[i] = ci; CTR[dir * 1024 + pp * 16 + cc] = cr; CTI[dir * 1024 + pp * 16 + cc] = ci; }
    }
    __syncthreads();
    for (int i = tid; i < 2048; i += 512) { const int dir = i >> 10, p = (i >> 4) & 63, c = i & 15;
        const float br = inp(F, IN_BRE)[((dir * 128 + g) * 64 + p) * 16 + c], bi = inp(F, IN_BIM)[((dir * 128 + g) * 64 + p) * 16 + c];
        const float fr = FR[dir * 64 + p], fi = FI[dir * 64 + p];
        BBR[i] = fr * br - fi * bi; BBI[i] = fr * bi + fi * br; }
    __syncthreads();
    { const int dir = tid >> 8, tau = (tid >> 4) & 15, cb = (tid >> 2) & 3, c2b = tid & 3;
        const LAS f32x4* ctr = (const LAS f32x4*)(CTR + dir * 1024) + cb; const LAS f32x4* cti = (const LAS f32x4*)(CTI + dir * 1024) + cb;
        const LAS f32x4* bbr = (const LAS f32x4*)(BBR + dir * 1024) + c2b; const LAS f32x4* bbi = (const LAS f32x4*)(BBI + dir * 1024) + c2b;
        const LAS float* pr = APR + (dir * 17 + tau) * 64; const LAS float* pi = API + (dir * 17 + tau) * 64;
        f32x4 k0 = {0.f, 0.f, 0.f, 0.f}, k1 = k0, k2 = k0, k3 = k0;
#pragma unroll 4
        for (int p = 0; p < 64; ++p) { const f32x4 cr = ctr[p * 4], ci = cti[p * 4], br = bbr[p * 4], bi = bbi[p * 4]; const float ar = pr[p], ai = pi[p];
            const f32x4 xr = cr * ar - ci * ai, xi = cr * ai + ci * ar;
            k0 += xr[0] * br - xi[0] * bi; k1 += xr[1] * br - xi[1] * bi; k2 += xr[2] * br - xi[2] * bi; k3 += xr[3] * br - xi[3] * bi; }
        LAS f32x4* ko = (LAS f32x4*)(KF + ((dir * 16 + tau) * 16 + 4 * cb) * 16) + c2b;
        ko[0] = k0; ko[4] = k1; ko[8] = k2; ko[12] = k3; }
    __syncthreads();
    bf16* B1 = (bf16*)(F.ws + WS_S5B1) + (size_t)g * 512 * 256; bf16* B2 = (bf16*)(F.ws + WS_S5B2) + (size_t)g * 256 * 256;
    const float* dsk = inp(F, IN_DSKIP) + g * 16;
    for (int id = tid; id < 8192; id += 512) { const int n = id >> 5, k8 = id & 31, t = n >> 4, c = n & 15, s = k8 >> 1, c0 = (k8 & 1) * 8; float v[8];
#pragma unroll
        for (int j = 0; j < 8; ++j) { const int c2 = c0 + j; float x = 0.f;
            if (s <= t) x += KF[((0 * 16 + (t - s)) * 16 + c) * 16 + c2];
            if (s >= t) x += KF[((1 * 16 + (s - t)) * 16 + c) * 16 + c2];
            if (s == t && c == c2) x += dsk[c];
            v[j] = x; }
        v4u o; o.x = pk2(v[0], v[1]); o.y = pk2(v[2], v[3]); o.z = pk2(v[4], v[5]); o.w = pk2(v[6], v[7]);
        *(GAS v4u*)(B1 + (size_t)n * 256 + k8 * 8) = o; }
    for (int id = tid; id < 8192; id += 512) { const int hc = id >> 5, k8 = id & 31, dir = hc >> 7, ri = (hc >> 6) & 1, p = hc & 63, s = k8 >> 1, c0 = (k8 & 1) * 8;
        const int e = dir ? s : 15 - s; const float er = APR[(dir * 17 + e) * 64 + p], ei = API[(dir * 17 + e) * 64 + p]; float v[8];
#pragma unroll
        for (int j = 0; j < 8; ++j) { const float br = BBR[dir * 1024 + p * 16 + c0 + j], bi = BBI[dir * 1024 + p * 16 + c0 + j]; v[j] = ri ? (er * bi + ei * br) : (er * br - ei * bi); }
        v4u o; o.x = pk2(v[0], v[1]); o.y = pk2(v[2], v[3]); o.z = pk2(v[4], v[5]); o.w = pk2(v[6], v[7]);
        *(GAS v4u*)(B1 + (size_t)(256 + hc) * 256 + k8 * 8) = o; }
    for (int id = tid; id < 8192; id += 512) { const int n = id >> 5, k8 = id & 31, t = n >> 4, c = n & 15, dir = k8 >> 4, ri = (k8 >> 3) & 1, p0 = (k8 & 7) * 8;
        const int e = dir ? 16 - t : t + 1; float v[8];
#pragma unroll
        for (int j = 0; j < 8; ++j) { const int p = p0 + j; const float er = APR[(dir * 17 + e) * 64 + p], ei = API[(dir * 17 + e) * 64 + p], cr = CR[(dir * 16 + c) * 64 + p], ci = CI[(dir * 16 + c) * 64 + p];
            v[j] = ri ? -(cr * ei + ci * er) : (cr * er - ci * ei); }
        v4u o; o.x = pk2(v[0], v[1]); o.y = pk2(v[2], v[3]); o.z = pk2(v[4], v[5]); o.w = pk2(v[6], v[7]);
        *(GAS v4u*)(B2 + (size_t)n * 256 + k8 * 8) = o; }
    __syncthreads();
}
__device__ __forceinline__ int qi8(float x) { return __float2int_rn(x) & 0xff; }
__device__ __forceinline__ void gu_slab_load(const float* src, int ldw, f32x4 (&a)[16]) {
#pragma unroll
    for (int i = 0; i < 16; ++i) a[i] = *(const GAS f32x4*)(src + (size_t)i * ldw);
}
__device__ __forceinline__ void gu_slab_store(unsigned char* dst, const f32x4 (&a)[16], const f32x4 inv) {
#pragma unroll
    for (int j = 0; j < 4; ++j) { unsigned w[4];
#pragma unroll
        for (int t = 0; t < 4; ++t) w[t] = (unsigned)qi8(a[4 * t][j] * inv[j]) | ((unsigned)qi8(a[4 * t + 1][j] * inv[j]) << 8) | ((unsigned)qi8(a[4 * t + 2][j] * inv[j]) << 16) | ((unsigned)qi8(a[4 * t + 3][j] * inv[j]) << 24);
        v4u o; o.x = w[0]; o.y = w[1]; o.z = w[2]; o.w = w[3];
        *(GAS v4u*)(dst + (size_t)j * D) = o; }
}
constexpr int GUC_WAVE = 16 * 1056, GUC_END = 8 * GUC_WAVE;
__device__ __forceinline__ void gu_slab_store_bf(unsigned char* dst, const v2u (&c)[16], const f32x4 inv) {
#pragma unroll
    for (int j = 0; j < 4; ++j) { unsigned w[4];
#pragma unroll
        for (int t = 0; t < 4; ++t) { float x[4];
#pragma unroll
            for (int e = 0; e < 4; ++e) { const v2u v = c[4 * t + e]; const unsigned wd = j < 2 ? v.x : v.y; x[e] = (j & 1) ? bfhi(wd) : bflo(wd); }
            w[t] = (unsigned)qi8(x[0] * inv[j]) | ((unsigned)qi8(x[1] * inv[j]) << 8) | ((unsigned)qi8(x[2] * inv[j]) << 16) | ((unsigned)qi8(x[3] * inv[j]) << 24); }
        v4u o; o.x = w[0]; o.y = w[1]; o.z = w[2]; o.w = w[3];
        *(GAS v4u*)(dst + (size_t)j * D) = o; }
}
template <int CTRL> __device__ __forceinline__ float dppf(float v) { return __builtin_bit_cast(float, __builtin_amdgcn_mov_dpp(__builtin_bit_cast(int, v), CTRL, 0xF, 0xF, true)); }
__device__ __forceinline__ float lx1(float v) { return dppf<0xB1>(v); }
__device__ __forceinline__ float lx2(float v) { return dppf<0x4E>(v); }
__device__ __forceinline__ float lx4(float v) { return dppf<0x141>(dppf<0x1B>(v)); }
__device__ __forceinline__ void had32_item(f32x4 (&a)[16], int lane) {
#pragma unroll
    for (int h = 1; h < 16; h <<= 1)
#pragma unroll
        for (int i = 0; i < 16; ++i) if (!(i & h)) { const f32x4 x = a[i], y = a[i + h]; a[i] = x + y; a[i + h] = x - y; }
    const bool up = (lane & 1) != 0;
#pragma unroll
    for (int i = 0; i < 16; ++i) { f32x4 p; p.x = lx1(a[i].x); p.y = lx1(a[i].y); p.z = lx1(a[i].z); p.w = lx1(a[i].w);
        a[i] = (up ? p - a[i] : a[i] + p) * 0.17677669529663687f; }
}
__device__ __forceinline__ void gu_slab(Frame& F, int slab) {
    const int tid = F.tid, lane = F.lane, wave = F.wave;
    const int which = slab >= 1504 ? 3 : (slab >= 1376 ? 2 : (slab >= 688 ? 1 : 0)), nb = which == 3 ? slab - 1504 : slab - 688 * which, pn = nb >> 3, q = nb & 7;
    const int src_col = which == 3 ? (nb < 32 ? 32 * nb : (nb < 96 ? 4096 + 32 * (nb - 32) : 6176 + 32 * (nb - 96))) : (which == 2 ? 32 * nb : (q < 4 ? 128 * pn + 32 * q : DFF + 128 * pn + 32 * (q - 4))), dst_row = 32 * nb;
    const int ldw = which == 3 ? D_IN_SRC : (which == 2 ? D : NGU);
    const float* W = inp(F, which == 3 ? IN_WIN : (which == 2 ? IN_WOUT : (which ? IN_WGU2 : IN_WGU1)));
    unsigned char* WT = F.ws + (which == 3 ? WS_FFO + 64 * MiB : (which == 2 ? WS_WOUT : (which ? WS_WGU2 : WS_WGU1))); float* SWp = (float*)(F.ws + WS_SW) + (which == 3 ? 2 * NGU + D : which * NGU);
    LAS unsigned char* CW = F.lds + wave * GUC_WAVE;
    LAS float* cm = (LAS float*)(F.lds + GUC_END); LAS float* isc = cm + 256;
    const int kc = lane & 7, nq = lane >> 3;
    const float* src = W + (size_t)(512 * wave + 16 * kc) * ldw + src_col + 4 * nq; unsigned char* dst = WT + (size_t)(dst_row + 4 * nq) * D + 512 * wave + 16 * kc;
    v2u P[2][16]; f32x4 m4 = {0.f, 0.f, 0.f, 0.f};
#pragma unroll
    for (int it = 0; it < 2; ++it) { f32x4 a[16];
        gu_slab_load(src + (size_t)(128 * it) * ldw, ldw, a);
        if (which == 2) had32_item(a, lane);
#pragma unroll
        for (int j = 0; j < 16; ++j) { const f32x4 v = a[j]; m4.x = fmaxf(m4.x, fabsf(v.x)); m4.y = fmaxf(m4.y, fabsf(v.y)); m4.z = fmaxf(m4.z, fabsf(v.z)); m4.w = fmaxf(m4.w, fabsf(v.w));
            P[it][j].x = pk2(v.x, v.y); P[it][j].y = pk2(v.z, v.w); } }
#pragma unroll 1
    for (int it = 2; it < 4; ++it) { f32x4 a[16];
        gu_slab_load(src + (size_t)(128 * it) * ldw, ldw, a);
        if (which == 2) had32_item(a, lane);
#pragma unroll
        for (int j = 0; j < 16; ++j) { const f32x4 v = a[j]; m4.x = fmaxf(m4.x, fabsf(v.x)); m4.y = fmaxf(m4.y, fabsf(v.y)); m4.z = fmaxf(m4.z, fabsf(v.z)); m4.w = fmaxf(m4.w, fabsf(v.w));
            v2u o; o.x = pk2(v.x, v.y); o.y = pk2(v.z, v.w); *(LAS v2u*)(CW + (8 * (it - 2) + kc) * 1056 + j * 64 + nq * 8) = o; } }
#pragma unroll
    for (int j = 0; j < 4; ++j) { m4[j] = fmaxf(m4[j], __shfl_xor(m4[j], 1)); m4[j] = fmaxf(m4[j], __shfl_xor(m4[j], 2)); m4[j] = fmaxf(m4[j], __shfl_xor(m4[j], 4)); }
    if (kc == 0) *(LAS f32x4*)(cm + wave * 32 + 4 * nq) = m4;
    __syncthreads();
    if (tid < 32) { float mx = 0.f;
#pragma unroll
        for (int w = 0; w < 8; ++w) mx = fmaxf(mx, cm[w * 32 + tid]);
        const float sc = mx > 0.f ? mx * (1.0f / 127.0f) : 1.0f; SWp[dst_row + tid] = sc; isc[tid] = 1.0f / sc; }
    __syncthreads();
    { const f32x4 inv = *(const LAS f32x4*)(isc + 4 * nq);
      v2u C[16];
#pragma unroll
      for (int it = 0; it < 2; ++it) {
#pragma unroll
          for (int i = 0; i < 16; ++i) C[i] = *(const LAS v2u*)(CW + (8 * it + kc) * 1056 + i * 64 + nq * 8);
          gu_slab_store_bf(dst + 256 + 128 * it, C, inv); }
      gu_slab_store_bf(dst, P[0], inv);
      gu_slab_store_bf(dst + 128, P[1], inv); }
    __syncthreads();
}
#ifndef P0DUP
#define P0DUP 0
#endif
__device__ __forceinline__ void p0_prologue(Frame& F) {
    const int tid = F.tid, lane = F.lane, wave = F.wave;
    LAS float* S = (LAS float*)(F.lds);
    for (int i = tid; i < 3 * D; i += 512) { const int mi = i >> 12, k = i & 4095; const float c = mi == 0 ? inp(F, IN_CCTX)[k] : inp(F, IN_C)[(mi - 1) * D + k]; S[i] = c / (1.0f + expf(-c)); }
    __syncthreads();
    _Pragma("unroll 1") for (int r_ = 0; r_ < ((P0DUP & 1) ? 2 : 1); ++r_)
    for (int g = blockIdx.x; g < 128; g += F.G) s5_prep(F, g);
    {
        LAS float* red = (LAS float*)(F.lds + 49152);
        float* MODP = (float*)(F.ws + WS_MODP);
        _Pragma("unroll 1") for (int r_ = 0; r_ < ((P0DUP & 2) ? 2 : 1); ++r_)
        for (int it = blockIdx.x; it < 576; it += F.G) {
            const int ct = it % 144, kq = it / 144;
            f32x4 a0 = {0.f, 0.f, 0.f, 0.f}, a1 = a0, a2 = a0;
            const float* wp = inp(F, IN_WADA) + (size_t)(1024 * kq + 128 * wave) * NMODC + 256 * ct + 4 * lane;
            const LAS float* sp = S + 1024 * kq + 128 * wave;
#pragma unroll 16
            for (int i = 0; i < 128; ++i) { const f32x4 v = *(const GAS f32x4*)(wp + (size_t)i * NMODC); const float s0 = sp[i], s1 = sp[D + i], s2 = sp[2 * D + i];
                a0 += s0 * v; a1 += s1 * v; a2 += s2 * v; }
            *(LAS f32x4*)(red + (wave * 3 + 0) * 256 + 4 * lane) = a0; *(LAS f32x4*)(red + (wave * 3 + 1) * 256 + 4 * lane) = a1; *(LAS f32x4*)(red + (wave * 3 + 2) * 256 + 4 * lane) = a2;
            __syncthreads();
            for (int o = tid; o < 768; o += 512) { const int mi = o >> 8, c = o & 255; float sum = 0.f;
#pragma unroll
                for (int w = 0; w < 8; ++w) sum += red[(w * 3 + mi) * 256 + c];
                MODP[(size_t)(kq * 3 + mi) * NMODC + 256 * ct + c] = sum; }
            __syncthreads();
        }
    }
    _Pragma("unroll 1") for (int r_ = 0; r_ < ((P0DUP & 4) ? 2 : 1); ++r_)
    for (int sl = blockIdx.x; sl < 1664; sl += F.G) gu_slab(F, sl);
    for (int e = blockIdx.x * 512 + tid; e < 2048; e += F.G * 512) { const int pos = e >> 5, i = e & 31; const float fq = powf(10000.0f, -(float)i / 32.0f), ang = (float)pos * fq;
        float* r = (float*)(F.ws + WS_ROPE) + e * 2; r[0] = cosf(ang); r[1] = sinf(ang); }
    {
        unsigned* ctr = (unsigned*)(F.ctl + CW_QUEUE);
        unsigned nb_v = 0u;
        if (lane == 0) nb_v = __hip_atomic_fetch_add(ctr, 8u, RLX_AGENT);
        int base = __builtin_amdgcn_readfirstlane((int)nb_v), pos = 0;
        if (lane == 0) nb_v = __hip_atomic_fetch_add(ctr, 8u, RLX_AGENT);
        f32x4 A[16], B[16];
        int itA = base, itB;
        TrDesc dA = tr_decode(F, itA, lane), dB; tr_load(dA, A);
        for (;;) {
            if (itA >= TR_NITEMS) break;
            if (++pos == 8) { base = __builtin_amdgcn_readfirstlane((int)nb_v); pos = 0; if (lane == 0) nb_v = __hip_atomic_fetch_add(ctr, 8u, RLX_AGENT); }
            itB = base + pos; dB = tr_decode(F, itB, lane); tr_load(dB, B);
            tr_store(dA, A);
            if (itB >= TR_NITEMS) break;
            if (++pos == 8) { base = __builtin_amdgcn_readfirstlane((int)nb_v); pos = 0; if (lane == 0) nb_v = __hip_atomic_fetch_add(ctr, 8u, RLX_AGENT); }
            itA = base + pos; dA = tr_decode(F, itA, lane); tr_load(dA, A);
            tr_store(dB, B);
        }
    }
}

__device__ __forceinline__ f32x4 modv(const float* MODP, const float* bada, int mi, int chunk, int c4) {
    f32x4 r = *((const GAS f32x4*)(bada + chunk * D) + c4);
#pragma unroll
    for (int kq = 0; kq < 4; ++kq) r += *((const GAS f32x4*)(MODP + (size_t)(kq * 3 + mi) * NMODC + chunk * D) + c4);
    return r; }
__device__ __forceinline__ f32x4 bf4(v2u w) { return (f32x4){bflo(w.x), bfhi(w.x), bflo(w.y), bfhi(w.y)}; }
template <int MODE> __device__ __forceinline__ void norm_phase(Frame& F) {
    const int gw = F.vcu * NWAVES + F.wave, NGW = F.G * NWAVES, lane = F.lane, tid = F.tid;
    const float* NW = inp(F, IN_NORMW); const float* MODP = (const float*)(F.ws + WS_MODP); const float* BADA = inp(F, IN_BADA);
    bf16* X1 = (bf16*)(F.ws + WS_X1); const bf16* FFO = (const bf16*)(F.ws + WS_FFO); bf16* H = (bf16*)(F.ws + WS_H);
    LAS f32x4* LG = (LAS f32x4*)F.lds; LAS f32x4* LA = LG + 1024; LAS f32x4* LS = LG + 2048;
    constexpr int gch = MODE == 1 ? 2 : (MODE == 2 ? 5 : 8), nwa = MODE == 1 ? 1 : (MODE == 2 ? 3 : 5); constexpr float gs = MODE == 2 ? 1.0f : 0.5f;
    constexpr int sh = MODE == 0 ? 0 : (MODE == 1 ? 3 : 6), sc = sh + 1, nwb = MODE == 0 ? 0 : (MODE == 1 ? 2 : 4);
    int staged = -1;
    for (int m = gw; m < M; m += NGW) {
        const int mi = mod_idx(m);
        if (mi != staged) {
            __syncthreads();
#pragma unroll
            for (int e = 0; e < 2; ++e) { const int c4 = tid * 2 + e;
                if (MODE != 0) { const f32x4 g = modv(MODP, BADA, mi, gch, c4), w = *((const GAS f32x4*)(NW + nwa * D) + c4); LG[c4] = (g * w) * gs; }
                if (MODE != 3) { const f32x4 w = *((const GAS f32x4*)(NW + nwb * D) + c4), c = modv(MODP, BADA, mi, sc, c4), s2 = modv(MODP, BADA, mi, sh, c4); LA[c4] = w * (1.0f + c); LS[c4] = s2; } }
            __syncthreads();
            staged = mi;
        }
        f32x4 v[16];
        if (MODE == 0) {
            const GAS f32x4* xr = (const GAS f32x4*)xrow(F, m) + lane;
#pragma unroll
            for (int j = 0; j < 16; ++j) v[j] = xr[64 * j];
        } else {
            const GAS v2u* fr = (const GAS v2u*)(FFO + (size_t)m * D) + lane; float ss = 0.f;
            const GAS f32x4* xr = (const GAS f32x4*)(MODE == 1 ? xrow(F, m) : nullptr) + lane; const GAS v2u* xb = (const GAS v2u*)(X1 + (size_t)m * D) + lane;
            v2u fw[16]; f32x4 xf[MODE == 1 ? 16 : 1]; v2u xw[MODE == 1 ? 1 : 16];
#pragma unroll
            for (int j = 0; j < 16; ++j) fw[j] = fr[64 * j];
#pragma unroll
            for (int j = 0; j < 16; ++j) { if (MODE == 1) xf[j] = xr[64 * j]; else xw[j] = xb[64 * j]; }
#pragma unroll
            for (int j = 0; j < 16; ++j) { v[j] = bf4(fw[j]); ss += (v[j].x * v[j].x + v[j].y * v[j].y) + (v[j].z * v[j].z + v[j].w * v[j].w); }
            const float r = 1.0f / sqrtf(wave_sum(ss) * (1.f / D) + EPS);
            GAS f32x4* orow = (GAS f32x4*)(F.out + OUT_Y + (size_t)m * D) + lane; GAS v2u* ob = (GAS v2u*)(X1 + (size_t)m * D) + lane;
#pragma unroll
            for (int j = 0; j < 16; ++j) { const f32x4 x = MODE == 1 ? xf[MODE == 1 ? j : 0] : bf4(xw[MODE == 1 ? 0 : j]); v[j] = x + (v[j] * r) * LG[lane + 64 * j];
                if (MODE == 3) orow[64 * j] = v[j]; else { v2u o; o.x = pk2(v[j].x, v[j].y); o.y = pk2(v[j].z, v[j].w); ob[64 * j] = o; } }
        }
        if (MODE != 3) {
            float ss = 0.f;
#pragma unroll
            for (int j = 0; j < 16; ++j) ss += (v[j].x * v[j].x + v[j].y * v[j].y) + (v[j].z * v[j].z + v[j].w * v[j].w);
            const float r = 1.0f / sqrtf(wave_sum(ss) * (1.f / D) + EPS);
            GAS v2u* o8 = (GAS v2u*)(H + (size_t)m * D) + lane; GAS unsigned* o4 = (GAS unsigned*)((unsigned char*)H + (size_t)m * D) + lane;
            if (MK_FP8 && MODE != 1) {
                float mx = 0.f;
#pragma unroll
                for (int j = 0; j < 16; ++j) { v[j] = (v[j] * r) * LA[lane + 64 * j] + LS[lane + 64 * j];
                    mx = fmaxf(fmaxf(mx, fmaxf(fabsf(v[j].x), fabsf(v[j].y))), fmaxf(fabsf(v[j].z), fabsf(v[j].w))); }
#pragma unroll
                for (int o = 1; o < 64; o <<= 1) mx = fmaxf(mx, __shfl_xor(mx, o));
                const float scl = mx > 0.f ? mx * (1.0f / 127.0f) : 1.0f, inv = 1.0f / scl;
                if (lane == 0) ((float*)(F.ws + WS_SA))[m] = scl;
#pragma unroll
                for (int j = 0; j < 16; ++j) o4[64 * j] = (unsigned)qi8(v[j].x * inv) | ((unsigned)qi8(v[j].y * inv) << 8) | ((unsigned)qi8(v[j].z * inv) << 16) | ((unsigned)qi8(v[j].w * inv) << 24);
            } else {
                float mx = 0.f;
#pragma unroll
                for (int j = 0; j < 16; ++j) { const f32x4 h = (v[j] * r) * LA[lane + 64 * j] + LS[lane + 64 * j]; v[j] = h;
                    mx = fmaxf(fmaxf(mx, fmaxf(fabsf(h.x), fabsf(h.y))), fmaxf(fabsf(h.z), fabsf(h.w)));
                    v2u o; o.x = pk2(h.x, h.y); o.y = pk2(h.z, h.w); o8[64 * j] = o; }
                if (MK_FP8 && MODE == 1) {
#pragma unroll
                    for (int o = 1; o < 64; o <<= 1) mx = fmaxf(mx, __shfl_xor(mx, o));
                    const float scl = mx > 0.f ? mx * (1.0f / 127.0f) : 1.0f, inv = 1.0f / scl;
                    if (lane == 0) ((float*)(F.ws + WS_SA))[m] = scl;
                    GAS unsigned* q4 = (GAS unsigned*)(F.ws + WS_ACT + (size_t)m * D) + lane;
#pragma unroll
                    for (int j = 0; j < 16; ++j) q4[64 * j] = (unsigned)qi8(v[j].x * inv) | ((unsigned)qi8(v[j].y * inv) << 8) | ((unsigned)qi8(v[j].z * inv) << 16) | ((unsigned)qi8(v[j].w * inv) << 24);
                }
            }
        }
    }
    __syncthreads();
}
__device__ __forceinline__ f32x4 had32_act(const f32x4 v, float s1, float s2, float s4) {
    const f32x4 a = {v.x + v.y, v.x - v.y, v.z + v.w, v.z - v.w};
    f32x4 b = {a.x + a.z, a.y + a.w, a.x - a.z, a.y - a.w};
    { f32x4 p; p.x = lx1(b.x); p.y = lx1(b.y); p.z = lx1(b.z); p.w = lx1(b.w); b = b * s1 + p; }
    { f32x4 p; p.x = lx2(b.x); p.y = lx2(b.y); p.z = lx2(b.z); p.w = lx2(b.w); b = b * s2 + p; }
    { f32x4 p; p.x = lx4(b.x); p.y = lx4(b.y); p.z = lx4(b.z); p.w = lx4(b.w); b = b * s4 + p; }
    return b * 0.17677669529663687f;
}
__device__ __forceinline__ unsigned q4i8(const f32x4 v, float inv) { return (unsigned)qi8(v.x * inv) | ((unsigned)qi8(v.y * inv) << 8) | ((unsigned)qi8(v.z * inv) << 16) | ((unsigned)qi8(v.w * inv) << 24); }
__device__ __forceinline__ void gla_post_phase(Frame& F) {
    const int gw = F.vcu * NWAVES + F.wave, NGW = F.G * NWAVES, lane = F.lane;
    const bf16* OFp = (const bf16*)(F.ws + WS_OF); const bf16* OBp = (const bf16*)(F.ws + WS_OB); const bf16* PROJ = (const bf16*)(F.ws + WS_PROJ); const bf16* CAT = (const bf16*)(F.ws + WS_CAT);
    unsigned char* CATQ = F.ws + WS_H; float* SA2 = (float*)(F.ws + WS_SA);
    const float hs1 = (lane & 1) ? -1.f : 1.f, hs2 = (lane & 2) ? -1.f : 1.f, hs4 = (lane & 4) ? -1.f : 1.f;
    const f32x4 gn = *((const GAS f32x4*)inp(F, IN_GNW) + lane);
    for (int m = gw; m < M; m += NGW) {
        const GAS v2u* a = (const GAS v2u*)(OFp + (size_t)m * SW) + lane; const GAS v2u* b = (const GAS v2u*)(OBp + (size_t)m * SW) + lane;
        const GAS v2u* gp = (const GAS v2u*)(PROJ + (size_t)m * NIN + PJ_G) + lane; const GAS v2u* sp = (const GAS v2u*)(CAT + (size_t)m * D + SW) + lane;
        GAS unsigned* op = (GAS unsigned*)(CATQ + (size_t)m * D) + lane;
        v2u ra[8], rb[8], rg[8], rs[8]; f32x4 ov[8], ys[8]; float ssq[8];
#pragma unroll
        for (int j = 0; j < 8; ++j) { ra[j] = a[64 * j]; rb[j] = b[64 * j]; rg[j] = gp[64 * j]; rs[j] = sp[64 * j]; }
#pragma unroll
        for (int j = 0; j < 8; ++j) { ov[j] = bf4(ra[j]) + bf4(rb[j]); ssq[j] = (ov[j].x * ov[j].x + ov[j].y * ov[j].y) + (ov[j].z * ov[j].z + ov[j].w * ov[j].w); }
#pragma unroll
        for (int o = 1; o < 64; o <<= 1) {
#pragma unroll
            for (int j = 0; j < 8; ++j) ssq[j] += __shfl_xor(ssq[j], o); }
        float amax = 0.f;
#pragma unroll
        for (int j = 0; j < 8; ++j) { const f32x4 o = ov[j]; const v2u gw2 = rg[j]; const float r = 1.0f / sqrtf(ssq[j] * (1.f / 256.f) + EPS);
            const float g0 = bflo(gw2.x), g1 = bfhi(gw2.x), g2 = bflo(gw2.y), g3 = bfhi(gw2.y);
            f32x4 x; x.x = o.x * r * gn.x * (g0 / (1.0f + __expf(-g0))); x.y = o.y * r * gn.y * (g1 / (1.0f + __expf(-g1))); x.z = o.z * r * gn.z * (g2 / (1.0f + __expf(-g2))); x.w = o.w * r * gn.w * (g3 / (1.0f + __expf(-g3)));
            x = had32_act(x, hs1, hs2, hs4); const f32x4 y = had32_act(bf4(rs[j]), hs1, hs2, hs4); ov[j] = x; ys[j] = y;
            amax = fmaxf(amax, fmaxf(fmaxf(fabsf(x.x), fabsf(x.y)), fmaxf(fabsf(x.z), fabsf(x.w)))); amax = fmaxf(amax, fmaxf(fmaxf(fabsf(y.x), fabsf(y.y)), fmaxf(fabsf(y.z), fabsf(y.w)))); }
#pragma unroll
        for (int o = 1; o < 64; o <<= 1) amax = fmaxf(amax, __shfl_xor(amax, o));
        const float sc = amax > 0.f ? amax * (1.0f / 127.0f) : 1.0f, inv = 1.0f / sc;
#pragma unroll
        for (int j = 0; j < 8; ++j) { op[64 * j] = q4i8(ov[j], inv); op[512 + 64 * j] = q4i8(ys[j], inv); }
        if (lane == 0) SA2[m] = sc;
    }
}

__device__ __forceinline__ void lr_mini_gemm(Frame& F) {
    const bf16* H = (const bf16*)(F.ws + WS_H); const bf16* WL = (const bf16*)(F.ws + WS_WLR); float* LR = (float*)(F.ws + WS_LR);
    LAS float* red = (LAS float*)F.lds;
    const int lane = F.lane, wave = F.wave, n16 = lane & 15, kq = lane >> 4;
    for (int rb = blockIdx.x; rb < M / 32; rb += F.G) {
        const int r0 = 32 * rb;
        f32x4 acc[2][2];
#pragma unroll
        for (int a = 0; a < 2; ++a)
#pragma unroll
            for (int b = 0; b < 2; ++b) acc[a][b] = (f32x4){0.f, 0.f, 0.f, 0.f};
#pragma unroll 4
        for (int ks = 0; ks < 16; ++ks) { const int k = 512 * wave + 32 * ks + 8 * kq;
            bf16x8 av[2], bv[2];
#pragma unroll
            for (int a = 0; a < 2; ++a) { av[a] = *(const GAS bf16x8*)(H + (size_t)(r0 + 16 * a + n16) * D + k); bv[a] = *(const GAS bf16x8*)(WL + (size_t)(16 * a + n16) * D + k); }
#pragma unroll
            for (int a = 0; a < 2; ++a)
#pragma unroll
                for (int b = 0; b < 2; ++b) acc[a][b] = __builtin_amdgcn_mfma_f32_16x16x32_bf16(av[a], bv[b], acc[a][b], 0, 0, 0);
        }
        __syncthreads();
#pragma unroll
        for (int a = 0; a < 2; ++a)
#pragma unroll
            for (int b = 0; b < 2; ++b)
#pragma unroll
                for (int i = 0; i < 4; ++i) red[(wave * 32 + 16 * a + 4 * kq + i) * 32 + 16 * b + n16] = acc[a][b][i];
        __syncthreads();
#pragma unroll
        for (int j = 0; j < 2; ++j) { const int o = F.tid + 512 * j; float s = 0.f;
#pragma unroll
            for (int w = 0; w < 8; ++w) s += red[w * 1024 + o];
            LR[(size_t)r0 * 32 + o] = s; }
    }
    __syncthreads();
}

constexpr int GI_P = 0, GI_QE = 9216, GI_KDT = 26624, GI_EB = 45056, GI_BYTES = 45568, GV_SLICE = 9216, GV_BYTES = 36864;
constexpr int GP_QS = 0, GP_KS = 17408, GP_IMG = 34816, GP_VT = GP_IMG + GI_BYTES, GP_LRS = GP_VT + GV_BYTES, GP_TOTS = GP_LRS + 4096;
__device__ __forceinline__ float log_sigmoid_f(float x) { return fminf(x, 0.f) - __logf(1.0f + __expf(-fabsf(x))); }
__device__ __forceinline__ void gla_prep_unit(Frame& F, int u) {
    LAS unsigned char* L = F.lds;
    const int tid = F.tid, lane = F.lane, w = F.wave, hh = lane >> 5, l31 = lane & 31;
    const int col = tid & 127, tg = tid >> 7;
    int b, h, d, ci, rowbase, rope;
    if (u < 1024) { b = u >> 9; h = (u >> 6) & 7; d = (u >> 5) & 1; ci = u & 31; rowbase = MP + b * 2048; rope = 1; }
    else { const int v = u - 1024; b = v >> 6; h = (v >> 3) & 7; d = (v >> 2) & 1; ci = v & 3; rowbase = b * 256; rope = 0; }
    const int m0 = rowbase + 64 * ci;
    const bf16* PROJ = (const bf16*)(F.ws + WS_PROJ); const float* LRp = (const float*)(F.ws + WS_LR); const float* ROPE = (const float*)(F.ws + WS_ROPE);
    unsigned short qv[16], kv[16];
#pragma unroll
    for (int tt = 0; tt < 16; ++tt) { const size_t m = (size_t)(m0 + 16 * tg + tt); qv[tt] = PROJ[m * NIN + PJ_Q + h * 128 + col]; kv[tt] = PROJ[m * NIN + PJ_K + h * 128 + col]; }
    float Wg[16];
#pragma unroll
    for (int r = 0; r < 16; ++r) Wg[r] = inp(F, IN_WGATE)[(d * 16 + r) * 1024 + h * 128 + col];
    const float bg = inp(F, IN_BGATE)[d * 1024 + h * 128 + col];
    __syncthreads();
    if (tid < 256) { const int tok = tid >> 2, r4 = tid & 3; *(LAS f32x4*)(L + GP_LRS + tok * 64 + r4 * 16) = *(const GAS f32x4*)(LRp + (size_t)(m0 + tok) * 32 + d * 16 + r4 * 4); }
    if (d == 0) {
        const int dv = tid & 255, half = tid >> 8; unsigned short vv[32];
#pragma unroll
        for (int j = 0; j < 32; ++j) vv[j] = PROJ[(size_t)(m0 + 32 * half + j) * NIN + PJ_V + h * 256 + dv];
#pragma unroll
        for (int j4 = 0; j4 < 4; ++j4) { v4u o; o.x = vv[8 * j4] | ((unsigned)vv[8 * j4 + 1] << 16); o.y = vv[8 * j4 + 2] | ((unsigned)vv[8 * j4 + 3] << 16); o.z = vv[8 * j4 + 4] | ((unsigned)vv[8 * j4 + 5] << 16); o.w = vv[8 * j4 + 6] | ((unsigned)vv[8 * j4 + 7] << 16);
            *(LAS v4u*)(L + GP_VT + (dv >> 6) * GV_SLICE + (dv & 63) * 144 + half * 64 + j4 * 16) = o; }
    }
    __syncthreads();
    float c[16];
#pragma unroll
    for (int tt = 0; tt < 16; ++tt) { const LAS f32x4* lp = (const LAS f32x4*)(L + GP_LRS + (16 * tg + tt) * 64); float lg = bg;
#pragma unroll
        for (int r4 = 0; r4 < 4; ++r4) { const f32x4 x = lp[r4]; lg += x.x * Wg[4 * r4] + x.y * Wg[4 * r4 + 1] + x.z * Wg[4 * r4 + 2] + x.w * Wg[4 * r4 + 3]; }
        c[tt] = log_sigmoid_f(lg) * (1.0f / 16.0f); }
    if (d == 0) {
#pragma unroll
        for (int tt = 1; tt < 16; ++tt) c[tt] += c[tt - 1];
    } else {
#pragma unroll
        for (int tt = 14; tt >= 0; --tt) c[tt] += c[tt + 1];
    }
    ((LAS float*)(L + GP_TOTS))[tg * 128 + col] = d ? c[0] : c[15];
    __syncthreads();
    const float t0 = ((LAS float*)(L + GP_TOTS))[col], t1 = ((LAS float*)(L + GP_TOTS))[128 + col], t2 = ((LAS float*)(L + GP_TOTS))[256 + col], t3 = ((LAS float*)(L + GP_TOTS))[384 + col];
    float off, ref; const float blast = (t0 + t1) + (t2 + t3);
    if (d == 0) { off = tg == 0 ? 0.f : (tg == 1 ? t0 : (tg == 2 ? t0 + t1 : t0 + t1 + t2)); ref = t0 + t1; }
    else { off = tg == 3 ? 0.f : (tg == 2 ? t3 : (tg == 1 ? t3 + t2 : t3 + t2 + t1)); ref = t2 + t3; }
    if (tg == 0) ((LAS float*)(L + GP_IMG + GI_EB))[col] = __expf(blast);
    const float e_ref = __expf(ref), e_lr = __expf(blast - ref);
    unsigned short kd[16];
#pragma unroll
    for (int tt = 0; tt < 16; ++tt) { const int tok = 16 * tg + tt;
        float q = bf2f(qv[tt]), k = bf2f(kv[tt]);
        if (rope) { const float qp = __shfl_xor(q, 32), kp = __shfl_xor(k, 32); const int pos = col < 64 ? ci : tok; const f32x2 cs = *(const GAS f32x2*)(ROPE + (pos * 32 + (col & 31)) * 2);
            if ((col & 32) == 0) { q = q * cs.x - qp * cs.y; k = k * cs.x - kp * cs.y; } else { q = qp * cs.y + q * cs.x; k = kp * cs.y + k * cs.x; } }
        q *= 0.08838834764831845f;
        const float bc = c[tt] + off;
        const float e1 = __expf(bc - ref), e2 = __builtin_amdgcn_rcpf(e1); const float qs = q * e1, ks = k * e2;
        ((LAS unsigned short*)(L + GP_QS + tok * 272))[col] = (unsigned short)f2bf(qs);
        ((LAS unsigned short*)(L + GP_KS + tok * 272))[col] = (unsigned short)f2bf(ks);
        ((LAS unsigned short*)(L + GP_IMG + GI_QE + tok * 272))[col] = (unsigned short)f2bf(qs * e_ref);
        kd[tt] = (unsigned short)f2bf(ks * e_lr); }
    { v4u o0, o1; o0.x = kd[0] | ((unsigned)kd[1] << 16); o0.y = kd[2] | ((unsigned)kd[3] << 16); o0.z = kd[4] | ((unsigned)kd[5] << 16); o0.w = kd[6] | ((unsigned)kd[7] << 16);
      o1.x = kd[8] | ((unsigned)kd[9] << 16); o1.y = kd[10] | ((unsigned)kd[11] << 16); o1.z = kd[12] | ((unsigned)kd[13] << 16); o1.w = kd[14] | ((unsigned)kd[15] << 16);
      *(LAS v4u*)(L + GP_IMG + GI_KDT + col * 144 + tg * 32) = o0; *(LAS v4u*)(L + GP_IMG + GI_KDT + col * 144 + tg * 32 + 16) = o1; }
    __syncthreads();
    if (w < 4) {
        const int ib = w >> 1, jb = w & 1; const bool zero = d == 0 ? (ib == 0 && jb == 1) : (ib == 1 && jb == 0);
        f32x16 X;
#pragma unroll
        for (int r = 0; r < 16; ++r) X[r] = 0.f;
        if (!zero) {
#pragma unroll
            for (int ks = 0; ks < 8; ++ks) { const bf16x8 a = *(const LAS bf16x8*)(L + GP_KS + (jb * 32 + l31) * 272 + ks * 32 + hh * 16), bq = *(const LAS bf16x8*)(L + GP_QS + (ib * 32 + l31) * 272 + ks * 32 + hh * 16);
                X = __builtin_amdgcn_mfma_f32_32x32x16_bf16(a, bq, X, 0, 0, 0); }
        }
        const int ig = ib * 32 + l31;
#pragma unroll
        for (int gq = 0; gq < 4; ++gq) { const int j0 = jb * 32 + 8 * gq + 4 * hh; float x[4];
#pragma unroll
            for (int e = 0; e < 4; ++e) { const int j = j0 + e; const bool keep = d == 0 ? (ig >= j) : (ig <= j); x[e] = keep ? X[4 * gq + e] : 0.f; }
            v2u o; o.x = pk2(x[0], x[1]); o.y = pk2(x[2], x[3]); *(LAS v2u*)(L + GP_IMG + GI_P + ig * 144 + j0 * 2) = o; }
    }
    __syncthreads();
    { unsigned char* gi = F.ws + WS_GLAW + (size_t)u * GI_BYTES;
      for (int i = tid; i < GI_BYTES / 16; i += 512) *(GAS v4u*)(gi + i * 16) = *(const LAS v4u*)(L + GP_IMG + i * 16);
      if (d == 0) { unsigned char* gv = F.ws + WS_VTW + (size_t)((m0 >> 6) * 8 + h) * GV_BYTES;
          for (int i = tid; i < GV_BYTES / 16; i += 512) *(GAS v4u*)(gv + i * 16) = *(const LAS v4u*)(L + GP_VT + i * 16); } }
}

constexpr int GS_BUF = GI_BYTES + GV_SLICE, GS_ST = 2 * GS_BUF, GS_NLD = 8;
__device__ __forceinline__ void gla_write_st(LAS unsigned char* L, const f32x16& S, int kb, int vb, int l31, int hh) {
#pragma unroll
    for (int gq = 0; gq < 4; ++gq) { v2u w; w.x = pk2(S[4 * gq + 0], S[4 * gq + 1]); w.y = pk2(S[4 * gq + 2], S[4 * gq + 3]);
        *(LAS v2u*)(L + GS_ST + (vb * 32 + l31) * 272 + (kb * 32 + 8 * gq + 4 * hh) * 2) = w; }
}
__device__ __forceinline__ void gla_scan_load(__amdgpu_buffer_rsrc_t rI, __amdgpu_buffer_rsrc_t rV, int soI, int soV, int tid, v4u (&R)[GS_NLD]) {
#pragma unroll
    for (int j = 0; j < 6; ++j) R[j] = __builtin_amdgcn_raw_buffer_load_b128(rI, tid * 16, soI + j * 8192, 0);
    R[6] = __builtin_amdgcn_raw_buffer_load_b128(rV, tid * 16, soV, 0);
    R[7] = __builtin_amdgcn_raw_buffer_load_b128(rV, tid * 16, soV + 8192, 0);
}
__device__ __forceinline__ void gla_scan_put(LAS unsigned char* buf, int tid, const v4u (&R)[GS_NLD]) {
#pragma unroll
    for (int j = 0; j < 5; ++j) *(LAS v4u*)(buf + (tid + 512 * j) * 16) = R[j];
    if (tid < 288) *(LAS v4u*)(buf + (tid + 2560) * 16) = R[5];
    *(LAS v4u*)(buf + GI_BYTES + tid * 16) = R[6];
    if (tid < 64) *(LAS v4u*)(buf + GI_BYTES + (tid + 512) * 16) = R[7];
}
__device__ __forceinline__ void gla_scan_mma(LAS unsigned char* L, LAS unsigned char* B, f32x16& S, __amdgpu_buffer_rsrc_t rO, int m0, int h, int vs, int w, int l31, int hh) {
    const int kb = w >> 1, vb = w & 1;
    if (w < 4) {
        const int ib = w >> 1, vb2 = w & 1; f32x16 O, O2, O3;
#pragma unroll
        for (int r = 0; r < 16; ++r) { O[r] = 0.f; O2[r] = 0.f; O3[r] = 0.f; }
#pragma unroll
        for (int ks = 0; ks < 4; ++ks) { const bf16x8 a = *(const LAS bf16x8*)(B + GI_BYTES + (vb2 * 32 + l31) * 144 + ks * 32 + hh * 16), bp = *(const LAS bf16x8*)(B + GI_P + (ib * 32 + l31) * 144 + ks * 32 + hh * 16);
            O = __builtin_amdgcn_mfma_f32_32x32x16_bf16(a, bp, O, 0, 0, 0);
            const bf16x8 a2 = *(const LAS bf16x8*)(L + GS_ST + (vb2 * 32 + l31) * 272 + ks * 32 + hh * 16), bq2 = *(const LAS bf16x8*)(B + GI_QE + (ib * 32 + l31) * 272 + ks * 32 + hh * 16);
            O2 = __builtin_amdgcn_mfma_f32_32x32x16_bf16(a2, bq2, O2, 0, 0, 0);
            const bf16x8 a3 = *(const LAS bf16x8*)(L + GS_ST + (vb2 * 32 + l31) * 272 + (ks + 4) * 32 + hh * 16), bq3 = *(const LAS bf16x8*)(B + GI_QE + (ib * 32 + l31) * 272 + (ks + 4) * 32 + hh * 16);
            O3 = __builtin_amdgcn_mfma_f32_32x32x16_bf16(a3, bq3, O3, 0, 0, 0); }
#pragma unroll
        for (int r = 0; r < 16; ++r) O[r] += O2[r] + O3[r];
        const int voff = ((m0 + ib * 32 + l31) * SW + h * 256 + vs * 64 + vb2 * 32 + 4 * hh) * 2;
#pragma unroll
        for (int gq = 0; gq < 4; ++gq) { v2u o; o.x = pk2(O[4 * gq], O[4 * gq + 1]); o.y = pk2(O[4 * gq + 2], O[4 * gq + 3]);
            __builtin_amdgcn_raw_buffer_store_b64(o, rO, voff + gq * 16, 0, 0); }
    }
    const LAS float* eb = (const LAS float*)(B + GI_EB);
#pragma unroll
    for (int reg = 0; reg < 16; ++reg) S[reg] *= eb[kb * 32 + (reg & 3) + 8 * (reg >> 2) + 4 * hh];
#pragma unroll
    for (int ks = 0; ks < 4; ++ks) { const bf16x8 a = *(const LAS bf16x8*)(B + GI_KDT + (kb * 32 + l31) * 144 + ks * 32 + hh * 16), bv = *(const LAS bf16x8*)(B + GI_BYTES + (vb * 32 + l31) * 144 + ks * 32 + hh * 16);
        S = __builtin_amdgcn_mfma_f32_32x32x16_bf16(a, bv, S, 0, 0, 0); }
}
__device__ __forceinline__ void gla_scan_item(Frame& F, int latent, int b, int h, int d, int vs, const float* S0, float* Sout) {
    LAS unsigned char* L = F.lds;
    const int tid = F.tid, lane = F.lane, w = F.wave, hh = lane >> 5, l31 = lane & 31;
    const int nch = latent ? 32 : 4, rowbase = latent ? MP + b * 2048 : b * 256;
    const int ubase = latent ? ((b << 9) | (h << 6) | (d << 5)) : 1024 + ((b << 6) | (h << 3) | (d << 2));
    const __amdgpu_buffer_rsrc_t rI = __builtin_amdgcn_make_buffer_rsrc((void*)(F.ws + WS_GLAW), 0, 2048 * GI_BYTES, 0x00020000);
    const __amdgpu_buffer_rsrc_t rV = __builtin_amdgcn_make_buffer_rsrc((void*)(F.ws + WS_VTW), 0, 1024 * GV_BYTES, 0x00020000);
    const __amdgpu_buffer_rsrc_t rO = __builtin_amdgcn_make_buffer_rsrc((void*)(F.ws + (d ? WS_OB : WS_OF)), 0, M * SW * 2, 0x00020000);
    const int kb = w >> 1, vb = w & 1;
    const int vbase = ((rowbase >> 6) * 8 + h) * GV_BYTES + vs * GV_SLICE;
#define GLA_CI(cc) (d ? nch - 1 - (cc) : (cc))
#define GLA_CL(cc) ((cc) < nch ? (cc) : nch - 1)
#define GLA_LOAD(R, cc) gla_scan_load(rI, rV, (ubase + GLA_CI(GLA_CL(cc))) * GI_BYTES, vbase + GLA_CI(GLA_CL(cc)) * 8 * GV_BYTES, tid, R)
    f32x16 S;
#pragma unroll
    for (int reg = 0; reg < 16; ++reg) { const int dk = kb * 32 + (reg & 3) + 8 * (reg >> 2) + 4 * hh, dv = vs * 64 + vb * 32 + l31; S[reg] = S0 ? S0[dk * 256 + dv] : 0.f; }
    v4u R0[GS_NLD], R1[GS_NLD];
    GLA_LOAD(R0, 0); GLA_LOAD(R1, 1);
    __syncthreads();
    gla_write_st(L, S, kb, vb, l31, hh);
    gla_scan_put(L, tid, R0);
    GLA_LOAD(R0, 2);
    __syncthreads();
    for (int cc = 0; cc < nch; cc += 2) {
        gla_scan_mma(L, L, S, rO, rowbase + 64 * GLA_CI(cc), h, vs, w, l31, hh);
        __syncthreads();
        gla_write_st(L, S, kb, vb, l31, hh);
        gla_scan_put(L + GS_BUF, tid, R1);
        GLA_LOAD(R1, cc + 3);
        __syncthreads();
        gla_scan_mma(L, L + GS_BUF, S, rO, rowbase + 64 * GLA_CI(cc + 1), h, vs, w, l31, hh);
        __syncthreads();
        gla_write_st(L, S, kb, vb, l31, hh);
        if (cc + 2 < nch) gla_scan_put(L, tid, R0);
        GLA_LOAD(R0, cc + 4);
        __syncthreads();
    }
#undef GLA_CI
#undef GLA_CL
#undef GLA_LOAD
    if (Sout) {
#pragma unroll
        for (int reg = 0; reg < 16; ++reg) { const int dk = kb * 32 + (reg & 3) + 8 * (reg >> 2) + 4 * hh, dv = vs * 64 + vb * 32 + l31; Sout[dk * 256 + dv] = S[reg]; }
    }
}

constexpr int S5_ASTR = 528, S5_HSTR = 1040;
constexpr float YQ_S = 8.0f;
__device__ __forceinline__ float gelu_tanh_f(float x) { const float z = 0.7978845608028654f * (x + 0.044715f * x * x * x); return x * __builtin_amdgcn_rcpf(1.0f + __expf(-2.0f * z)); }
__device__ __forceinline__ void s5_unit(Frame& F, int g, int q) {
    LAS unsigned char* L = F.lds;
    const int tid = F.tid, lane = F.lane, w = F.wave, n16 = lane & 15, kq = lane >> 4;
    const bf16* PROJ = (const bf16*)(F.ws + WS_PROJ); bf16* YS5 = (bf16*)(F.ws + WS_YS5); unsigned char* YQ8 = F.ws + WS_ACT;
    const int mbase = q * 2048;
    __syncthreads();
    for (int i = tid; i < 2048; i += 512) { const int r = i >> 4, s = i & 15; const GAS v4u* src = (const GAS v4u*)(PROJ + (size_t)(mbase + 16 * r + s) * NIN + PJ_U + g * 16);
        const v4u v0 = src[0], v1 = src[1]; *(LAS v4u*)(L + r * S5_ASTR + s * 32) = v0; *(LAS v4u*)(L + r * S5_ASTR + s * 32 + 16) = v1; }
    __syncthreads();
    f32x4 Y[8][2], Hh[8][2];
#pragma unroll
    for (int rb = 0; rb < 8; ++rb)
#pragma unroll
        for (int cb = 0; cb < 2; ++cb) { Y[rb][cb] = (f32x4){0.f, 0.f, 0.f, 0.f}; Hh[rb][cb] = (f32x4){0.f, 0.f, 0.f, 0.f}; }
    const bf16* B1 = (const bf16*)(F.ws + WS_S5B1) + (size_t)g * 512 * 256;
#pragma unroll 2
    for (int ks = 0; ks < 8; ++ks) {
        bf16x8 by[2], bh[2];
#pragma unroll
        for (int cb = 0; cb < 2; ++cb) { by[cb] = *(const GAS bf16x8*)(B1 + (size_t)(32 * w + 16 * cb + n16) * 256 + 32 * ks + 8 * kq); bh[cb] = *(const GAS bf16x8*)(B1 + (size_t)(256 + 32 * w + 16 * cb + n16) * 256 + 32 * ks + 8 * kq); }
#pragma unroll
        for (int rb = 0; rb < 8; ++rb) { const bf16x8 a = *(const LAS bf16x8*)(L + (16 * rb + n16) * S5_ASTR + ks * 64 + kq * 16);
#pragma unroll
            for (int cb = 0; cb < 2; ++cb) { Y[rb][cb] = __builtin_amdgcn_mfma_f32_16x16x32_bf16(a, by[cb], Y[rb][cb], 0, 0, 0); Hh[rb][cb] = __builtin_amdgcn_mfma_f32_16x16x32_bf16(a, bh[cb], Hh[rb][cb], 0, 0, 0); } }
    }
    __syncthreads();
#pragma unroll
    for (int rb = 0; rb < 8; ++rb)
#pragma unroll
        for (int cb = 0; cb < 2; ++cb)
#pragma unroll
            for (int i = 0; i < 4; ++i) *(LAS float*)(L + (16 * rb + 4 * kq + i) * S5_HSTR + (32 * w + 16 * cb + n16) * 4) = Hh[rb][cb][i];
    __syncthreads();
    if (tid < 128) {
        const int dir = tid >> 6, p = tid & 63; const f32x2 a16 = *(const GAS f32x2*)((const float*)(F.ws + WS_A16) + ((g * 2 + dir) * 64 + p) * 2);
        const int colr = (dir * 128 + p) * 4, coli = (dir * 128 + 64 + p) * 4;
        if (q < 2) {
            for (int seq = 0; seq < 8; ++seq) { float hr = 0.f, hi = 0.f;
#pragma unroll
                for (int j8 = 0; j8 < 2; ++j8) { float lr[8], li[8];
#pragma unroll
                    for (int jj = 0; jj < 8; ++jj) { const int r = seq * 16 + (dir ? 15 - (j8 * 8 + jj) : j8 * 8 + jj); lr[jj] = *(const LAS float*)(L + r * S5_HSTR + colr); li[jj] = *(const LAS float*)(L + r * S5_HSTR + coli); }
#pragma unroll
                    for (int jj = 0; jj < 8; ++jj) { const int r = seq * 16 + (dir ? 15 - (j8 * 8 + jj) : j8 * 8 + jj); *(LAS float*)(L + r * S5_HSTR + colr) = hr; *(LAS float*)(L + r * S5_HSTR + coli) = hi;
                        const float nr = a16.x * hr - a16.y * hi + lr[jj], ni = a16.x * hi + a16.y * hr + li[jj]; hr = nr; hi = ni; } }
                const int b = q * 8 + seq; F.out[OUT_S5R + ((size_t)(b * 2 + dir) * 128 + g) * 64 + p] = hr; F.out[OUT_S5I + ((size_t)(b * 2 + dir) * 128 + g) * 64 + p] = hi; }
        } else {
            const int b = q - 2; float hr = inp(F, IN_SS5R)[((size_t)(b * 2 + dir) * 128 + g) * 64 + p], hi = inp(F, IN_SS5I)[((size_t)(b * 2 + dir) * 128 + g) * 64 + p];
            for (int j8 = 0; j8 < 16; ++j8) { float lr[8], li[8];
#pragma unroll
                for (int jj = 0; jj < 8; ++jj) { const int r0 = j8 * 8 + jj, r = dir ? 127 - r0 : r0; lr[jj] = *(const LAS float*)(L + r * S5_HSTR + colr); li[jj] = *(const LAS float*)(L + r * S5_HSTR + coli); }
#pragma unroll
                for (int jj = 0; jj < 8; ++jj) { const int r0 = j8 * 8 + jj, r = dir ? 127 - r0 : r0; *(LAS float*)(L + r * S5_HSTR + colr) = hr; *(LAS float*)(L + r * S5_HSTR + coli) = hi;
                    const float nr = a16.x * hr - a16.y * hi + lr[jj], ni = a16.x * hi + a16.y * hr + li[jj]; hr = nr; hi = ni; }
            }
        }
    }
    __syncthreads();
    const bf16* B2 = (const bf16*)(F.ws + WS_S5B2) + (size_t)g * 256 * 256;
#pragma unroll 2
    for (int ks = 0; ks < 8; ++ks) {
        bf16x8 b2[2];
#pragma unroll
        for (int cb = 0; cb < 2; ++cb) b2[cb] = *(const GAS bf16x8*)(B2 + (size_t)(32 * w + 16 * cb + n16) * 256 + 32 * ks + 8 * kq);
#pragma unroll
        for (int rb = 0; rb < 8; ++rb) { const LAS f32x4* hp = (const LAS f32x4*)(L + (16 * rb + n16) * S5_HSTR + (32 * ks + 8 * kq) * 4); const f32x4 lo = hp[0], hi = hp[1];
            v4u pk; pk.x = pk2(lo.x, lo.y); pk.y = pk2(lo.z, lo.w); pk.z = pk2(hi.x, hi.y); pk.w = pk2(hi.z, hi.w); const bf16x8 a = __builtin_bit_cast(bf16x8, pk);
#pragma unroll
            for (int cb = 0; cb < 2; ++cb) Y[rb][cb] = __builtin_amdgcn_mfma_f32_16x16x32_bf16(a, b2[cb], Y[rb][cb], 0, 0, 0); }
    }
#pragma unroll
    for (int rb = 0; rb < 8; ++rb)
#pragma unroll
        for (int cb = 0; cb < 2; ++cb)
        {
            const bool ev = (lane & 1) == 0; const int t = 2 * w + cb, c0 = g * 16 + (n16 & ~1);
            const float v0 = gelu_tanh_f(Y[rb][cb][0]), v1 = gelu_tanh_f(Y[rb][cb][1]), v2 = gelu_tanh_f(Y[rb][cb][2]), v3 = gelu_tanh_f(Y[rb][cb][3]);
            const float r0 = lx1(ev ? v2 : v0), r1 = lx1(ev ? v3 : v1);
            const float lo0 = ev ? v0 : r0, hi0 = ev ? r0 : v2, lo1 = ev ? v1 : r1, hi1 = ev ? r1 : v3;
            const size_t row0 = (size_t)(mbase + 16 * (16 * rb + 4 * kq + (ev ? 0 : 2)) + t) * SW + c0, row1 = row0 + (size_t)16 * SW;
            *(GAS unsigned*)(YS5 + row0) = pk2(lo0, hi0); *(GAS unsigned*)(YS5 + row1) = pk2(lo1, hi1);
            *(GAS unsigned short*)(YQ8 + row0) = (unsigned short)__builtin_amdgcn_cvt_pk_fp8_f32(__builtin_amdgcn_fmed3f(lo0 * YQ_S, -448.f, 448.f), __builtin_amdgcn_fmed3f(hi0 * YQ_S, -448.f, 448.f), 0, false);
            *(GAS unsigned short*)(YQ8 + row1) = (unsigned short)__builtin_amdgcn_cvt_pk_fp8_f32(__builtin_amdgcn_fmed3f(lo1 * YQ_S, -448.f, 448.f), __builtin_amdgcn_fmed3f(hi1 * YQ_S, -448.f, 448.f), 0, false); }
}

struct Args { const float* in[29]; float* out; unsigned char* ws; int ph_lo, ph_hi; };
static_assert(sizeof(Args) == 31 * 8 + 8, "Args has no padding");
#ifndef R6A
#define R6A 1
#endif
#ifndef R6B
#define R6B 1
#endif
#ifndef R7
#define R7 1
#endif
#ifndef PG8_SP2
#define PG8_SP2 true
#endif
#ifndef PG8_ALIGN
#define PG8_ALIGN true
#endif
struct MapOrder {
    pg8::StaticOrder S; int kind;
    __device__ __forceinline__ bool next(int i, pg8::Unit& u) const {
        if (S.next(i, u)) { if (kind) u.pn += 4; return true; }
        const int L = i * S.G + S.c - 384; if (L < 0 || L >= 128) return false;
        u.pm = (kind ? 0 : 16) + (L & 15); u.pn = (kind ? 24 : 12) + (L >> 4); return true; }
    __device__ __forceinline__ void a_ready(const pg8::Unit&) const {}
    __device__ __forceinline__ void done(const pg8::Unit&) const {}
};
__global__ void __launch_bounds__(NWAVES * 64, 2) mk_fwd(Args args) {
    extern __shared__ __attribute__((aligned(16))) unsigned char lds[];
    Frame F;
    F.lds = (LAS unsigned char*)lds;
    F.MISC = (volatile LAS unsigned*)(F.lds + MISC_OFF);
    F.wave = __builtin_amdgcn_readfirstlane((int)threadIdx.x >> 6); F.lane = lane_now(); F.tid = F.wave * 64 + F.lane;
    F.G = gridDim.x; { const int bx = blockIdx.x; F.vcu = (F.G % 8 == 0) ? (bx % 8) * (F.G / 8) + bx / 8 : bx; }
    F.out = args.out; F.ws = args.ws; F.ctl = (gu32*)(args.ws + WS_CTL);
    if (F.tid < 32) ((LAS unsigned*)(F.lds + MISC_OFF))[F.tid] = 0u;
    if (F.tid < 29) *(LAS unsigned long long*)(F.lds + PTR_OFF + 8 * F.tid) = (unsigned long long)args.in[F.tid];
    __syncthreads();
    XcdBarrier bar; bar.bar = (unsigned*)(F.ctl + CW_BAR); bar.x = 0; bar.st = nullptr;
    if (!MK_PER_PHASE) bar = xcd_barrier_post((unsigned*)(F.ctl + CW_BAR), F.MISC + 8);
    const int lo = args.ph_lo, hi = args.ph_hi;
#define IN(k) (lo <= (k) && (k) < hi)
#ifndef MK_REP
#define MK_REP 0
#endif
#define REPS(k) (((MK_REP >> (k)) & 1) ? 2 : 1)
#define SEAM(k) do { if (IN(k) && IN((k) + 1)) xcd_barrier(bar); } while (0)
    bf16* const H = (bf16*)(F.ws + WS_H);

    if (IN(0)) _Pragma("unroll 1") for (int rep_ = 0; rep_ < REPS(0); ++rep_) { F.lane = lane_now(); F.tid = F.wave * 64 + F.lane; if (rep_) { VM_WAIT(); __syncthreads(); } p0_prologue(F); } SEAM(0);
    if (IN(1)) _Pragma("unroll 1") for (int rep_ = 0; rep_ < REPS(1); ++rep_) { F.lane = lane_now(); F.tid = F.wave * 64 + F.lane; if (rep_) { VM_WAIT(); __syncthreads(); } norm_phase<0>(F); } SEAM(1);
    if (IN(2)) _Pragma("unroll 1") for (int rep_ = 0; rep_ < REPS(2); ++rep_) { F.lane = lane_now(); F.tid = F.wave * 64 + F.lane; if (rep_) { VM_WAIT(); __syncthreads(); } pg8::Gemm g{H, (const bf16*)(F.ws + WS_WGU1), M, NGU, MK_FP8 ? D / 2 : D}; pg8::StaticOrder S; S.init(M, NGU, F.G, (int)blockIdx.x);
        pg8::EpiSwiGLU E{F.ws + WS_ACT, DFF, (const float*)(F.ws + WS_SA), (const float*)(F.ws + WS_SW) + 0 * NGU};
        pg8::gemm_phase<pg8::EpiSwiGLU, pg8::StaticOrder, PG8_ALIGN, PG8_SP2, 2>(F.lds + RING_OFF, g, S, E, F.wave); } SEAM(2);
    if (IN(3)) _Pragma("unroll 1") for (int rep_ = 0; rep_ < REPS(3); ++rep_) { F.lane = lane_now(); F.tid = F.wave * 64 + F.lane; if (rep_) { VM_WAIT(); __syncthreads(); } pg8::Gemm g{(const bf16*)(F.ws + WS_ACT), (const bf16*)(F.ws + WS_WDN1), M, D, DFF / 2}; pg8::StaticOrder S; S.init(M, D, F.G, (int)blockIdx.x);
        pg8::EpiBf16P E{(bf16*)(F.ws + WS_FFO), D};
        pg8::gemm_phase<pg8::EpiBf16P, pg8::StaticOrder, PG8_ALIGN, PG8_SP2, 1>(F.lds + RING_OFF, g, S, E, F.wave, 127 - 10, 127 - 2); } SEAM(3);
    if (IN(4)) _Pragma("unroll 1") for (int rep_ = 0; rep_ < REPS(4); ++rep_) { F.lane = lane_now(); F.tid = F.wave * 64 + F.lane; if (rep_) { VM_WAIT(); __syncthreads(); } norm_phase<1>(F); } SEAM(4);
    if (IN(5)) _Pragma("unroll 1") for (int rep_ = 0; rep_ < REPS(5); ++rep_) { F.lane = lane_now(); F.tid = F.wave * 64 + F.lane; if (rep_) { VM_WAIT(); __syncthreads(); }
        { pg8::Gemm g{H, (const bf16*)(F.ws + WS_WIN), M, NIN, D}; MapOrder S; S.S.init(M, 12 * 256, F.G, (int)blockIdx.x); S.kind = 1;
          pg8::EpiBf16P E{(bf16*)(F.ws + WS_PROJ), NIN};
          pg8::gemm_phase<pg8::EpiBf16P, MapOrder, PG8_ALIGN, PG8_SP2>(F.lds + RING_OFF, g, S, E, F.wave); }
        F.lane = lane_now(); F.tid = F.wave * 64 + F.lane;
        { pg8::Gemm g{(const bf16*)(F.ws + WS_ACT), (const bf16*)(F.ws + WS_FFO + 64 * MiB), M, 20 * 256, D / 2}; MapOrder S; S.S.init(M, 12 * 256, F.G, (int)blockIdx.x); S.kind = 0;
          pg8::EpiI8Bf16P E{(bf16*)(F.ws + WS_PROJ), NIN, (const float*)(F.ws + WS_SA), (const float*)(F.ws + WS_SW) + 2 * NGU + D, 4, 12};
          pg8::gemm_phase<pg8::EpiI8Bf16P, MapOrder, PG8_ALIGN, PG8_SP2, 2>(F.lds + RING_OFF, g, S, E, F.wave); }
        F.lane = lane_now(); F.tid = F.wave * 64 + F.lane;
        lr_mini_gemm(F); } SEAM(5);
    if (IN(6)) _Pragma("unroll 1") for (int rep_ = 0; rep_ < REPS(6); ++rep_) { F.lane = lane_now(); F.tid = F.wave * 64 + F.lane; if (rep_) { VM_WAIT(); __syncthreads(); }
        for (int u = blockIdx.x; u < 2048 * R6A; u += F.G) gla_prep_unit(F, u & 2047);
        for (int u = blockIdx.x; u < 512 * R6B; u += F.G) s5_unit(F, u & 127, (u >> 7) & 3);
    } SEAM(6);
    if (IN(7)) _Pragma("unroll 1") for (int rep_ = 0; rep_ < REPS(7); ++rep_) { F.lane = lane_now(); F.tid = F.wave * 64 + F.lane; if (rep_) { VM_WAIT(); __syncthreads(); }
        for (int u_ = blockIdx.x; u_ < 256 * R7; u_ += F.G) { const int u = u_ & 255;
            const int n_it = u < 128 ? 1 : 8;
            for (int e = 0; e < n_it; ++e) {
                int latent, b, h, d, vs; const float* S0; float* Sout;
                if (u < 128) { const int x = u & 7, j = u >> 3, grp = x + 8 * (j >> 2); latent = 1; vs = j & 3; b = grp >> 4; h = (grp >> 1) & 7; d = grp & 1;
                    S0 = inp(F, IN_SGLA) + ((size_t)(b * 2 + d) * 8 + h) * 32768; Sout = nullptr; }
                else { const int grp = (u - 128) * 2 + (e >> 2); latent = 0; vs = e & 3; b = grp >> 4; h = (grp >> 1) & 7; d = grp & 1;
                    S0 = nullptr; Sout = F.out + OUT_GLA + ((size_t)(b * 2 + d) * 8 + h) * 32768; }
                gla_scan_item(F, latent, b, h, d, vs, S0, Sout);
            }
        }
        F.lane = lane_now(); F.tid = F.wave * 64 + F.lane;
        { pg8::Gemm g{(const bf16*)(F.ws + WS_ACT), (const bf16*)(F.ws + WS_WGLU), M, SW, SW / 2}; pg8::StaticOrder S; S.init(M, SW, F.G, (int)blockIdx.x);
          pg8::EpiGlu E{(const bf16*)(F.ws + WS_YS5), SW, inp(F, IN_BGLU), (bf16*)(F.ws + WS_CAT), D, SW};
          pg8::gemm_phase<pg8::EpiGlu, pg8::StaticOrder, PG8_ALIGN, PG8_SP2, 1>(F.lds + RING_OFF, g, S, E, F.wave, 127 - 10, 127 - 3); }
    } SEAM(7);
    if (IN(8)) _Pragma("unroll 1") for (int rep_ = 0; rep_ < REPS(8); ++rep_) { F.lane = lane_now(); F.tid = F.wave * 64 + F.lane; if (rep_) { VM_WAIT(); __syncthreads(); }
        gla_post_phase(F); } SEAM(8);
    if (IN(9)) _Pragma("unroll 1") for (int rep_ = 0; rep_ < REPS(9); ++rep_) { F.lane = lane_now(); F.tid = F.wave * 64 + F.lane; if (rep_) { VM_WAIT(); __syncthreads(); } pg8::Gemm g{(const bf16*)(F.ws + WS_H), (const bf16*)(F.ws + WS_WOUT), M, D, D / 2}; pg8::StaticOrder S; S.init(M, D, F.G, (int)blockIdx.x);
        pg8::EpiI8Bf16P E{(bf16*)(F.ws + WS_FFO), D, (const float*)(F.ws + WS_SA), (const float*)(F.ws + WS_SW) + 2 * NGU, 1 << 30, 0};
        pg8::gemm_phase<pg8::EpiI8Bf16P, pg8::StaticOrder, PG8_ALIGN, PG8_SP2, 2>(F.lds + RING_OFF, g, S, E, F.wave); } SEAM(9);
    if (IN(10)) _Pragma("unroll 1") for (int rep_ = 0; rep_ < REPS(10); ++rep_) { F.lane = lane_now(); F.tid = F.wave * 64 + F.lane; if (rep_) { VM_WAIT(); __syncthreads(); } norm_phase<2>(F); } SEAM(10);
    if (IN(11)) _Pragma("unroll 1") for (int rep_ = 0; rep_ < REPS(11); ++rep_) { F.lane = lane_now(); F.tid = F.wave * 64 + F.lane; if (rep_) { VM_WAIT(); __syncthreads(); } pg8::Gemm g{H, (const bf16*)(F.ws + WS_WGU2), M, NGU, MK_FP8 ? D / 2 : D}; pg8::StaticOrder S; S.init(M, NGU, F.G, (int)blockIdx.x);
        pg8::EpiSwiGLU E{F.ws + WS_ACT, DFF, (const float*)(F.ws + WS_SA), (const float*)(F.ws + WS_SW) + 1 * NGU};
        pg8::gemm_phase<pg8::EpiSwiGLU, pg8::StaticOrder, PG8_ALIGN, PG8_SP2, 2>(F.lds + RING_OFF, g, S, E, F.wave); } SEAM(11);
    if (IN(12)) _Pragma("unroll 1") for (int rep_ = 0; rep_ < REPS(12); ++rep_) { F.lane = lane_now(); F.tid = F.wave * 64 + F.lane; if (rep_) { VM_WAIT(); __syncthreads(); } pg8::Gemm g{(const bf16*)(F.ws + WS_ACT), (const bf16*)(F.ws + WS_WDN2), M, D, DFF / 2}; pg8::StaticOrder S; S.init(M, D, F.G, (int)blockIdx.x);
        pg8::EpiBf16P E{(bf16*)(F.ws + WS_FFO), D};
        pg8::gemm_phase<pg8::EpiBf16P, pg8::StaticOrder, PG8_ALIGN, PG8_SP2, 1>(F.lds + RING_OFF, g, S, E, F.wave, 127 - 10, 127 - 2); } SEAM(12);
    if (IN(13)) _Pragma("unroll 1") for (int rep_ = 0; rep_ < REPS(13); ++rep_) { F.lane = lane_now(); F.tid = F.wave * 64 + F.lane; if (rep_) { VM_WAIT(); __syncthreads(); } norm_phase<3>(F); }
#ifdef XB_EXTRA
    _Pragma("unroll 1") for (int i_ = 0; i_ < XB_EXTRA; ++i_) xcd_barrier(bar);
#endif
#undef IN
#undef SEAM
}

extern "C" void kernel_launch(void* const* d_in, const int* in_sizes, int n_in, void* d_out, int out_size, void* d_ws, size_t ws_size, hipStream_t stream) {
    static int grid = 0;
    if (grid == 0) {
        if (n_in != 29 || out_size != (int)OUT_END || ws_size < WS_END) { fprintf(stderr, "kernel_launch: unexpected shapes (n_in %d, out %d, ws %zu; need ws >= %zu); nothing launched\n", n_in, out_size, ws_size, (size_t)WS_END); grid = -1; return; }
        int dev = 0, cus = 0, per_cu = 0;
        if (hipGetDevice(&dev) != hipSuccess || hipDeviceGetAttribute(&cus, hipDeviceAttributeMultiprocessorCount, dev) != hipSuccess) { grid = -1; return; }
        if (hipFuncSetAttribute((const void*)mk_fwd, hipFuncAttributeMaxDynamicSharedMemorySize, LDS_BYTES) != hipSuccess) { fprintf(stderr, "kernel_launch: hipFuncSetAttribute failed\n"); grid = -1; return; }
        if (hipOccupancyMaxActiveBlocksPerMultiprocessor(&per_cu, (const void*)mk_fwd, NWAVES * 64, LDS_BYTES) != hipSuccess || per_cu < 1) fprintf(stderr, "kernel_launch: occupancy query reports %d\n", per_cu);
        (void)hipGetLastError();
        grid = cus;
    }
    if (grid < 0) return;
    if (hipMemsetAsync((char*)d_ws + WS_CTL, 0, CTL_ZERO_BYTES, stream) != hipSuccess) { fprintf(stderr, "kernel_launch: memset failed\n"); return; }
    Args a{};
    for (int i = 0; i < 29; ++i) a.in[i] = (const float*)d_in[i];
    a.out = (float*)d_out; a.ws = (unsigned char*)d_ws;
#if MK_PER_PHASE
    for (int p = 0; p < NPH; ++p) { a.ph_lo = p; a.ph_hi = p + 1; hipLaunchKernelGGL(mk_fwd, dim3(grid), dim3(NWAVES * 64), LDS_BYTES, stream, a); }
#else
    a.ph_lo = 0; a.ph_hi = NPH; hipLaunchKernelGGL(mk_fwd, dim3(grid), dim3(NWAVES * 64), LDS_BYTES, stream, a);
#endif
    const hipError_t le = hipPeekAtLastError();
    if (le != hipSuccess) fprintf(stderr, "kernel_launch: launch failed: %s\n", hipGetErrorName(le));
}
```
